# Optimizing an MI355X kernel written in HIP

```python
import math
import jax, jax.numpy as jnp
from jax import lax
import numpy as np

D_MODEL = 1024
BATCH = 8
SEQ = 4096
DEPTH = 4
DEC_BATCH = 8
DEC_SEQ = 64
PAST_LEN = 2048

CHUNK = 64
Q_BLOCK = 128
RMS_EPS = 1e-6
N_MIXERS = 3
N_POOL_LAYERS = (DEPTH + 2) // 3
N_DN_LAYERS = (DEPTH + 1) // 3
N_SB_LAYERS = DEPTH // 3
POOL_WINDOWS = (2, 4, 8, 16)
POOL_GROUPS = len(POOL_WINDOWS)
POOL_GC = D_MODEL // POOL_GROUPS
POOL_BUF = max(POOL_WINDOWS) - 1
DN_HEADS = 8
DN_DK = D_MODEL // DN_HEADS
DN_DV = D_MODEL // DN_HEADS
DN_KW = DN_HEADS * DN_DK
DN_VW = DN_HEADS * DN_DV
DN_QKV = 2 * DN_KW + DN_VW
DN_CONV = 4
SB_HEADS = 16
SB_DH = D_MODEL // SB_HEADS
D_FF = ((8 * D_MODEL // 3 + 127) // 128) * 128
FFN_CONV = 3

kernel_name = "hybrid_pool_gdn_stickbreak_stream_step"


def _rmsnorm(x, g):
    xf = x.astype(jnp.float32)
    y = xf * lax.rsqrt(jnp.mean(xf * xf, axis=-1, keepdims=True) + RMS_EPS)
    return (y * g.astype(jnp.float32)).astype(x.dtype)


def _l2norm(x):
    xf = x.astype(jnp.float32)
    return xf * lax.rsqrt(jnp.sum(xf * xf, axis=-1, keepdims=True) + RMS_EPS)


def _causal_dwconv(x, buf, w):
    width = w.shape[0]
    L = x.shape[1]
    xp = jnp.concatenate([buf.astype(x.dtype), x], axis=1)
    y = xp[:, 0:L] * w[0]
    for i in range(1, width):
        y = y + xp[:, i:i + L] * w[i]
    return y, xp[:, xp.shape[1] - (width - 1):]


def _pool_mixer(h, buf, w, scale, start):
    B, L, D = h.shape
    ext = jnp.concatenate([buf.astype(h.dtype), h], axis=1).astype(jnp.float32)
    cs = jnp.concatenate([jnp.zeros((B, 1, D), jnp.float32), jnp.cumsum(ext, axis=1)], axis=1)
    n_avail = (start + jnp.arange(L) + 1).astype(jnp.float32)
    hi = cs[:, POOL_BUF + 1:]
    means = []
    for g, win in enumerate(POOL_WINDOWS):
        sl = slice(g * POOL_GC, (g + 1) * POOL_GC)
        lo = cs[:, POOL_BUF + 1 - win:POOL_BUF + 1 - win + L, sl]
        cnt = jnp.minimum(n_avail, float(win))
        means.append((hi[..., sl] - lo) / cnt[None, :, None])
    d = jnp.concatenate(means, axis=-1) - ext[:, POOL_BUF:]
    y = jnp.einsum('blgc,gce->blge', d.reshape(B, L, POOL_GROUPS, POOL_GC), w.astype(jnp.float32))
    y = y.reshape(B, L, D) * scale.astype(jnp.float32)
    return y.astype(h.dtype), ext[:, ext.shape[1] - POOL_BUF:].astype(buf.dtype)


def _gated_delta_chunked(q, k, v, beta, g, s0, chunk):
    B, L, H, DK = q.shape
    DV = v.shape[-1]
    n = L // chunk

    def blk(t):
        t = t.reshape((B, n, chunk, H) + t.shape[3:])
        return jnp.moveaxis(jnp.swapaxes(t, 2, 3), 1, 0)

    q, k, v, beta, g = blk(q), blk(k), blk(v), blk(beta), blk(g)
    gc = jnp.cumsum(g, axis=-1)
    idx = jnp.arange(chunk)
    lower_incl = idx[:, None] >= idx[None, :]
    lower_strict = idx[:, None] > idx[None, :]
    diff = gc[..., :, None] - gc[..., None, :]
    decay_incl = jnp.exp(jnp.where(lower_incl, diff, -jnp.inf))
    decay_strict = jnp.where(lower_strict, decay_incl, 0.0)
    kb = k * beta[..., None]
    m = jnp.einsum('nbhid,nbhjd->nbhij', kb, k) * decay_strict
    eye = jnp.eye(chunk, dtype=jnp.float32)
    rhs = jnp.concatenate([v * beta[..., None], kb * jnp.exp(gc)[..., None]], axis=-1)
    sol = lax.linalg.triangular_solve(eye + m, rhs, left_side=True, lower=True, unit_diagonal=True)
    u, w = sol[..., :DV], sol[..., DV:]
    attn = jnp.einsum('nbhid,nbhjd->nbhij', q, k) * decay_incl
    qg = q * jnp.exp(gc)[..., None]
    kg = k * jnp.exp(gc[..., -1:] - gc)[..., None]
    glast = jnp.exp(gc[..., -1])

    def step(s, xs):
        u_c, w_c, qg_c, kg_c, attn_c, gl_c = xs
        v_new = u_c - jnp.einsum('bhck,bhkv->bhcv', w_c, s)
        o_c = jnp.einsum('bhck,bhkv->bhcv', qg_c, s) + jnp.einsum('bhij,bhjv->bhiv', attn_c, v_new)
        s = s * gl_c[..., None, None] + jnp.einsum('bhck,bhcv->bhkv', kg_c, v_new)
        return s, o_c

    s_fin, o = lax.scan(step, s0, (u, w, qg, kg, attn, glast))
    o = jnp.swapaxes(jnp.moveaxis(o, 0, 1), 2, 3).reshape(B, L, H, DV)
    return o, s_fin


def _gated_delta_mixer(h, conv_buf, s0, w_in, conv_w, a_log, dt_bias, norm_w, w_out, chunk):
    B, L, _ = h.shape
    proj = h @ w_in
    qkv, z, a, b = jnp.split(proj, [DN_QKV, DN_QKV + DN_VW, DN_QKV + DN_VW + DN_HEADS], axis=-1)
    qkv, new_conv = _causal_dwconv(qkv, conv_buf, conv_w)
    qkv = jax.nn.silu(qkv)
    q, k, v = jnp.split(qkv, [DN_KW, 2 * DN_KW], axis=-1)
    q = _l2norm(q.reshape(B, L, DN_HEADS, DN_DK)) * (DN_DK ** -0.5)
    k = _l2norm(k.reshape(B, L, DN_HEADS, DN_DK))
    v = v.reshape(B, L, DN_HEADS, DN_DV).astype(jnp.float32)
    beta = jax.nn.sigmoid(b.astype(jnp.float32))
    g = -jnp.exp(a_log.astype(jnp.float32)) * jax.nn.softplus(a.astype(jnp.float32) + dt_bias.astype(jnp.float32))
    o, s_new = _gated_delta_chunked(q, k, v, beta, g, s0.astype(jnp.float32), chunk)
    o = _rmsnorm(o, norm_w) * jax.nn.silu(z.reshape(B, L, DN_HEADS, DN_DV).astype(jnp.float32))
    y = o.reshape(B, L, DN_VW).astype(h.dtype) @ w_out
    return y, new_conv, s_new.astype(s0.dtype)


def _sb_attend(q, k, v, q_pos, k_pos):
    z = jnp.einsum('bqhd,bshd->bhqs', q, k).astype(jnp.float32) * (SB_DH ** -0.5)
    mask = k_pos[None, :] < q_pos[:, None]
    log_1m = jnp.where(mask, jax.nn.log_sigmoid(-z), 0.0)
    rest = lax.cumsum(log_1m, axis=3, reverse=True) - log_1m
    a = jnp.where(mask, jnp.exp(jax.nn.log_sigmoid(z) + rest), 0.0)
    return jnp.einsum('bhqs,bshd->bqhd', a, v.astype(jnp.float32))


def _sb_mixer(h, k_past, v_past, w_qkv, w_out, start):
    B, L, _ = h.shape
    q, k, v = jnp.split(h @ w_qkv, 3, axis=-1)
    q = q.reshape(B, L, SB_HEADS, SB_DH)
    k = k.reshape(B, L, SB_HEADS, SB_DH)
    v = v.reshape(B, L, SB_HEADS, SB_DH)
    if k_past is None:
        nq = L // Q_BLOCK
        qb = jnp.moveaxis(q.reshape(B, nq, Q_BLOCK, SB_HEADS, SB_DH), 1, 0)
        pb = jnp.arange(L).reshape(nq, Q_BLOCK)
        k_pos = jnp.arange(L)
        o = lax.map(lambda qp: _sb_attend(qp[0], k, v, qp[1], k_pos), (qb, pb))
        o = jnp.moveaxis(o, 0, 1).reshape(B, L, SB_HEADS, SB_DH)
    else:
        k_all = jnp.concatenate([k_past.astype(k.dtype), k], axis=1)
        v_all = jnp.concatenate([v_past.astype(v.dtype), v], axis=1)
        o = _sb_attend(q, k_all, v_all, start + jnp.arange(L), jnp.arange(k_all.shape[1]))
    y = o.reshape(B, L, SB_HEADS * SB_DH).astype(h.dtype) @ w_out
    return y, k, v


def _conv_ffn(h, buf, w_up, conv_w, conv_b, w_down):
    val, gate = jnp.split(h @ w_up, 2, axis=-1)
    gate, new_buf = _causal_dwconv(gate, buf, conv_w)
    return (jax.nn.silu(gate + conv_b) * val) @ w_down, new_buf


def _trunk(x, pool_bufs, dn_conv_bufs, dn_states, sb_k_past, sb_v_past, ffn_bufs, start, dn_chunk, p):
    n_pool, n_dnc, n_dn, n_k, n_v, n_ffn = [], [], [], [], [], []
    for i in range(DEPTH):
        kind, j = i % N_MIXERS, i // N_MIXERS
        h = _rmsnorm(x, p['mix_norm'][i])
        if kind == 0:
            y, buf = _pool_mixer(h, pool_bufs[j], p['pool_w'][j], p['pool_scale'][j], start)
            n_pool.append(buf)
        elif kind == 1:
            y, cbuf, s = _gated_delta_mixer(h, dn_conv_bufs[j], dn_states[j], p['dn_w_in'][j], p['dn_conv_w'][j],
                                            p['dn_a_log'][j], p['dn_dt_bias'][j], p['dn_norm'][j],
                                            p['dn_w_out'][j], dn_chunk)
            n_dnc.append(cbuf)
            n_dn.append(s)
        else:
            kp = None if sb_k_past is None else sb_k_past[j]
            vp = None if sb_v_past is None else sb_v_past[j]
            y, kn, vn = _sb_mixer(h, kp, vp, p['sb_w_qkv'][j], p['sb_w_out'][j], start)
            n_k.append(kn)
            n_v.append(vn)
        x = x + y
        h = _rmsnorm(x, p['ffn_norm'][i])
        y, fbuf = _conv_ffn(h, ffn_bufs[i], p['ffn_w_up'][i], p['ffn_conv_w'][i], p['ffn_conv_b'][i],
                            p['ffn_w_down'][i])
        n_ffn.append(fbuf)
        x = x + y
    y = _rmsnorm(x, p['final_norm'])
    return (y, jnp.stack(n_pool), jnp.stack(n_dnc), jnp.stack(n_dn), jnp.stack(n_k), jnp.stack(n_v),
            jnp.stack(n_ffn))


def setup_inputs(seed: int = 0) -> dict:
    key = jax.random.key(seed)
    ks = list(jax.random.split(key, 32))
    f32 = jnp.float32

    def nrm(k, shape, fan_in):
        return jax.random.normal(k, shape, f32) * (fan_in ** -0.5)

    def gain(k, shape):
        return 1.0 + 0.02 * jax.random.normal(k, shape, f32)

    dt = jnp.exp(jax.random.uniform(ks[20], (N_DN_LAYERS, DN_HEADS), f32, math.log(1e-3), math.log(1e-1)))
    return {
        "x_prompt": jax.random.normal(ks[0], (BATCH, SEQ, D_MODEL), f32),
        "x_sample": jax.random.normal(ks[1], (DEC_BATCH, DEC_SEQ, D_MODEL), f32),
        "state_pool": jax.random.normal(ks[2], (N_POOL_LAYERS, DEC_BATCH, POOL_BUF, D_MODEL), f32),
        "state_dn_conv": jax.random.normal(ks[3], (N_DN_LAYERS, DEC_BATCH, DN_CONV - 1, DN_QKV), f32),
        "state_dn": 0.1 * jax.random.normal(ks[4], (N_DN_LAYERS, DEC_BATCH, DN_HEADS, DN_DK, DN_DV), f32),
        "cache_sb_k": jax.random.normal(ks[5], (N_SB_LAYERS, DEC_BATCH, PAST_LEN, SB_HEADS, SB_DH), f32),
        "cache_sb_v": jax.random.normal(ks[6], (N_SB_LAYERS, DEC_BATCH, PAST_LEN, SB_HEADS, SB_DH), f32),
        "state_ffn_conv": jax.random.normal(ks[7], (DEPTH, DEC_BATCH, FFN_CONV - 1, D_FF), f32),
        "mix_norm": gain(ks[8], (DEPTH, D_MODEL)),
        "ffn_norm": gain(ks[9], (DEPTH, D_MODEL)),
        "final_norm": gain(ks[10], (D_MODEL,)),
        "pool_w": nrm(ks[11], (N_POOL_LAYERS, POOL_GROUPS, POOL_GC, POOL_GC), POOL_GC),
        "pool_scale": gain(ks[12], (N_POOL_LAYERS, D_MODEL)),
        "dn_w_in": nrm(ks[13], (N_DN_LAYERS, D_MODEL, DN_QKV + DN_VW + 2 * DN_HEADS), D_MODEL),
        "dn_conv_w": nrm(ks[14], (N_DN_LAYERS, DN_CONV, DN_QKV), DN_CONV),
        "dn_a_log": jnp.log(jax.random.uniform(ks[15], (N_DN_LAYERS, DN_HEADS), f32, 1.0, 16.0)),
        "dn_dt_bias": jnp.log(jnp.expm1(dt)),
        "dn_norm": gain(ks[16], (N_DN_LAYERS, DN_DV)),
        "dn_w_out": nrm(ks[17], (N_DN_LAYERS, DN_VW, D_MODEL), DN_VW),
        "sb_w_qkv": nrm(ks[18], (N_SB_LAYERS, D_MODEL, 3 * SB_HEADS * SB_DH), D_MODEL),
        "sb_w_out": nrm(ks[19], (N_SB_LAYERS, SB_HEADS * SB_DH, D_MODEL), SB_HEADS * SB_DH),
        "ffn_w_up": nrm(ks[21], (DEPTH, D_MODEL, 2 * D_FF), D_MODEL),
        "ffn_conv_w": nrm(ks[22], (DEPTH, FFN_CONV, D_FF), FFN_CONV),
        "ffn_conv_b": 0.01 * jax.random.normal(ks[23], (DEPTH, D_FF), f32),
        "ffn_w_down": nrm(ks[24], (DEPTH, D_FF, D_MODEL), D_FF),
    }


def reference(x_prompt, x_sample, state_pool, state_dn_conv, state_dn, cache_sb_k, cache_sb_v, state_ffn_conv,
              mix_norm, ffn_norm, final_norm, pool_w, pool_scale, dn_w_in, dn_conv_w, dn_a_log, dn_dt_bias,
              dn_norm, dn_w_out, sb_w_qkv, sb_w_out, ffn_w_up, ffn_conv_w, ffn_conv_b, ffn_w_down):
    p = dict(mix_norm=mix_norm, ffn_norm=ffn_norm, final_norm=final_norm, pool_w=pool_w, pool_scale=pool_scale,
             dn_w_in=dn_w_in, dn_conv_w=dn_conv_w, dn_a_log=dn_a_log, dn_dt_bias=dn_dt_bias, dn_norm=dn_norm,
             dn_w_out=dn_w_out, sb_w_qkv=sb_w_qkv, sb_w_out=sb_w_out, ffn_w_up=ffn_w_up, ffn_conv_w=ffn_conv_w,
             ffn_conv_b=ffn_conv_b, ffn_w_down=ffn_w_down)
    bp = x_prompt.shape[0]
    dtp = x_prompt.dtype
    zero_pool = jnp.zeros((N_POOL_LAYERS, bp, POOL_BUF, D_MODEL), dtp)
    zero_dnc = jnp.zeros((N_DN_LAYERS, bp, DN_CONV - 1, DN_QKV), dtp)
    zero_dn = jnp.zeros((N_DN_LAYERS, bp, DN_HEADS, DN_DK, DN_DV), state_dn.dtype)
    zero_ffn = jnp.zeros((DEPTH, bp, FFN_CONV - 1, D_FF), dtp)
    y_prompt, pool_p, dnc_p, dn_p, k_p, v_p, ffn_p = _trunk(
        x_prompt, zero_pool, zero_dnc, zero_dn, None, None, zero_ffn, 0, CHUNK, p)
    y_sample, pool_s, dnc_s, dn_s, k_s, v_s, ffn_s = _trunk(
        x_sample, state_pool, state_dn_conv, state_dn, cache_sb_k, cache_sb_v, state_ffn_conv,
        PAST_LEN, x_sample.shape[1], p)
    return (y_prompt, y_sample, pool_p, pool_s, dnc_p, dnc_s, dn_p, dn_s, k_p, k_s, v_p, v_s, ffn_p, ffn_s)
```

```cpp
#include <hip/hip_runtime.h>
#include <hip/hip_cooperative_groups.h>
#include <cstdio>
#include <cstdint>
namespace cg = cooperative_groups;

#ifndef MK_ONE_LAUNCH
#define MK_ONE_LAUNCH 1
#endif

#define LAS __attribute__((address_space(3)))
typedef unsigned short bf16_t;
typedef short bf16x8 __attribute__((ext_vector_type(8)));
typedef float f32x2 __attribute__((ext_vector_type(2)));
typedef float f32x4 __attribute__((ext_vector_type(4)));
typedef float f32x16 __attribute__((ext_vector_type(16)));
typedef unsigned u32x2 __attribute__((ext_vector_type(2)));
typedef unsigned u32x4 __attribute__((ext_vector_type(4)));
typedef __bf16 bf16x2_t __attribute__((ext_vector_type(2)));
#define DI __device__ __forceinline__

constexpr int D = 1024, MP = 32768, MS = 512, MA = MP + MS, PAST = 2048, LK = PAST + 64;
constexpr int FF = 2816, NUP = 5632, DNQ = 3072, DNIN = 4112, DNINP = 4352;
constexpr int NSEG = MA / 64;
constexpr float EPS = 1e-6f;
constexpr size_t O_POOLP = (size_t)MA * D;
constexpr size_t O_POOLS = O_POOLP + 2 * 8 * 15 * D;
constexpr size_t O_DNCP = O_POOLS + 2 * 8 * 15 * D;
constexpr size_t O_DNCS = O_DNCP + 8 * 3 * DNQ;
constexpr size_t O_DNP = O_DNCS + 8 * 3 * DNQ;
constexpr size_t O_DNS = O_DNP + 8 * 8 * 128 * 128;
constexpr size_t O_KP = O_DNS + 8 * 8 * 128 * 128;
constexpr size_t O_KS = O_KP + (size_t)MP * D;
constexpr size_t O_VP = O_KS + (size_t)MS * D;
constexpr size_t O_VS = O_VP + (size_t)MP * D;
constexpr size_t O_FFNP = O_VS + (size_t)MS * D;
constexpr size_t O_FFNS = O_FFNP + 4 * 8 * 2 * FF;
constexpr size_t O_END = O_FFNS + 4 * 8 * 2 * FF;
constexpr size_t MiB = 1u << 20;
constexpr size_t WS_WUP = 0, WS_WDN = 11 * MiB, WS_WMIX = 17 * MiB, WS_WMIX2 = 26 * MiB, WS_AB = 28 * MiB, WS_GL = 31 * MiB, WS_HALO = 31 * MiB + 256 * 1024;
constexpr size_t WS_XN = 41 * MiB, WS_BIG = 106 * MiB;
constexpr size_t WS_V = WS_BIG, WS_SG0 = WS_BIG + 179 * MiB, WS_SV0 = WS_BIG + 191 * MiB, WS_SGL = WS_BIG + 203 * MiB, WS_PART = WS_BIG + 215 * MiB;
constexpr size_t WS_PRE = WS_BIG, WS_W = WS_BIG + 195 * MiB;
constexpr size_t WS_Q = WS_BIG, WS_KP = WS_Q + 65 * MiB, WS_VTP = WS_KP + 64 * MiB, WS_KS = WS_BIG + 260 * MiB, WS_VTS = WS_KS + 33 * MiB;
constexpr size_t WS_W2UP = 464 * MiB, WS_W2DN = 475 * MiB, WS_W2MIX = 481 * MiB, WS_W2MIX2 = 487 * MiB, WS_W3UP = 489 * MiB, WS_W3DN = 500 * MiB, WS_W3MIX = 506 * MiB;
constexpr size_t WS_CTL = 507 * MiB, CTL_BYTES = 65536;
constexpr size_t WS_END = 508 * MiB;
constexpr size_t WS_W1UP = WS_BIG + 326 * MiB, WS_W1DN = WS_BIG + 337 * MiB, WS_W1MIX = WS_BIG + 343 * MiB, WS_W1MIX2 = WS_BIG + 352 * MiB;
DI size_t w_up(int l) { return l == 0 ? WS_WUP : (l == 1 ? WS_W1UP : (l == 2 ? WS_W2UP : WS_W3UP)); }
DI size_t w_dn(int l) { return l == 0 ? WS_WDN : (l == 1 ? WS_W1DN : (l == 2 ? WS_W2DN : WS_W3DN)); }
DI size_t w_mix(int l) { return l == 0 ? WS_WMIX : (l == 1 ? WS_W1MIX : (l == 2 ? WS_W2MIX : WS_W3MIX)); }
DI size_t w_mix2(int l) { return l == 1 ? WS_W1MIX2 : WS_W2MIX2; }
constexpr int LDS_BYTES = 147456;

struct Params { const float* in[25]; float* out; unsigned char* ws; int lo, hi; };

DI unsigned pk2(float lo, float hi) { f32x2 v = {lo, hi}; bf16x2_t b = __builtin_convertvector(v, bf16x2_t); return __builtin_bit_cast(unsigned, b); }
DI float bflo(unsigned u) { return __uint_as_float(u << 16); }
DI float bfhi(unsigned u) { return __uint_as_float(u & 0xffff0000u); }
DI bf16_t f2bf(float f) { return (bf16_t)(pk2(f, 0.f) & 0xffffu); }
DI float bf2f(bf16_t b) { return __uint_as_float(((unsigned)b) << 16); }
DI int crow(int r, int hi) { return (r & 3) + 8 * (r >> 2) + 4 * hi; }
DI void rowinfo(int row, int& s, int& b, int& t) { if (row < MP) { s = 0; b = row >> 12; t = row & 4095; } else { const int r = row - MP; s = 1; b = r >> 6; t = r & 63; } }
DI float wave_sum(float v) {
#pragma unroll
    for (int o = 1; o < 64; o <<= 1) v += __shfl_xor(v, o);
    return v;
}
struct V8 { f32x4 a, b; };
DI V8 v8zero() { V8 r; r.a = (f32x4){0.f, 0.f, 0.f, 0.f}; r.b = r.a; return r; }
DI V8 v8_from_bf(u32x4 w) { V8 r; r.a = (f32x4){bflo(w.x), bfhi(w.x), bflo(w.y), bfhi(w.y)}; r.b = (f32x4){bflo(w.z), bfhi(w.z), bflo(w.w), bfhi(w.w)}; return r; }
DI V8 v8_ldf(const float* p) { V8 r; r.a = *(const f32x4*)p; r.b = *(const f32x4*)(p + 4); return r; }
DI V8 v8_ldbf(const bf16_t* p) { return v8_from_bf(*(const u32x4*)p); }
DI u32x4 v8_pack(const V8& v) { u32x4 w; w.x = pk2(v.a.x, v.a.y); w.y = pk2(v.a.z, v.a.w); w.z = pk2(v.b.x, v.b.y); w.w = pk2(v.b.z, v.b.w); return w; }
#define MFMA32(a, b, c) __builtin_amdgcn_mfma_f32_32x32x16_bf16((a), (b), (c), 0, 0, 0)

namespace pg8 {
constexpr int BM = 256, BK = 64, HALF = 128, HTB = HALF * BK * 2, STAGE_BYTES = 8 * HTB, NXCD = 8, WGM = 8;
DI int lds_byte(int r, int c) { const int st = (r >> 4) * 2 + (c >> 5), rr = r & 15, cc = c & 31, ob = rr * 64 + cc * 2; return st * 1024 + (ob ^ (((ob >> 9) & 1) << 5)); }
DI void stage_rc(int b, int& R, int& C) { const int st = b / 1024, sb = b % 1024, swz = sb ^ (((sb >> 9) & 1) << 5); R = (st >> 1) * 16 + swz / 64; C = (st & 1) * 32 + (swz % 64) / 2; }
DI int perm32(int rho) { const int n = rho >> 4, i = rho & 15; return 8 * (i >> 2) + 4 * n + (i & 3); }
struct Unit { int pm, pn, k0, np; };
struct Gemm { const bf16_t* A; const bf16_t* Bt; int M, N, K, lda, ldb, acol; };
struct StaticOrder {
    int nM, nN, nwg, G, c, npu;
    DI void init(int M, int N, int K, int G_, int c_) { nM = M / BM; nN = N / BM; nwg = nM * nN; G = G_; c = c_; npu = K / 128; }
    DI bool next(int i, Unit& u) const {
        const long L = (long)i * G + c; if (L >= nwg) return false;
        int wgid = (int)L; { const int q = nwg / NXCD, r = nwg % NXCD, xcd = wgid % NXCD, off = wgid / NXCD; wgid = (xcd < r ? xcd * (q + 1) : r * (q + 1) + (xcd - r) * q) + off; }
        const int nig = WGM * nN, gid = wgid / nig, fm = gid * WGM, gsz = (nM - fm) < WGM ? (nM - fm) : WGM;
        u.pm = fm + ((wgid % nig) % gsz); u.pn = (wgid % nig) / gsz; u.k0 = 0; u.np = npu; return true;
    }
};
struct ResOrder {
    StaticOrder so; int npu, G, c;
    DI void init(int K, int G_, int c_) { so.init(MP, D, K, G_, c_); npu = K / 128; G = G_; c = c_; }
    DI bool next(int i, Unit& u) const {
        const int rp = (512 + G - 1) / G;
        if (i < rp) { if (so.next(i, u)) return true; }
        const int j = i < rp ? rp : i;
        if (i < rp) return false;
        const long mi = (long)(j - rp) * G + c; if (mi >= 8 * npu) return false;
        const int unit = (int)(mi / npu); u.pm = 128 + unit / 4; u.pn = unit % 4; u.k0 = (int)(mi % npu); u.np = 1; return true;
    }
};
struct SampleUpOrder {
    int c;
    DI bool next(int i, Unit& u) const { if (i > 0 || c >= 44) return false; u.pm = 128 + c / 22; u.pn = c % 22; u.k0 = 0; u.np = 8; return true; }
};
template <class Epi, class Sched>
DI void gemm_phase(LAS unsigned char* lds, const Gemm g, const Sched& S, const Epi& E, const int tid) {
    const int wid = __builtin_amdgcn_readfirstlane(tid >> 6), lane = tid & 63, wr = wid >> 2, wc = wid & 3, fr = lane & 15, fq = lane >> 4;
    unsigned voffA[2], voffB[2];
#pragma unroll
    for (int i = 0; i < 2; ++i) { int R, C; stage_rc(tid * 16 + i * 8192, R, C); const int Rb = Epi::PERM ? ((R & ~31) + perm32(R & 31)) : R;
        voffA[i] = (unsigned)(R * g.lda + C) * 2u; voffB[i] = (unsigned)(Rb * g.ldb + C) * 2u; }
    const size_t kstep = (size_t)(BK * 2);
    const size_t hstepA = (size_t)HALF * g.lda * 2, hstepB = (size_t)HALF * g.ldb * 2;
    const size_t tstepA = 2 * hstepA, tstepB = 2 * hstepB;
    const unsigned ldsw = (unsigned)wid * 1024u;
    const int aoff = lds_byte(wr * 64 + fr, fq * 8), boff = lds_byte(wc * 32 + fr, fq * 8);
#define PG8_SA(b, h) (((b) * 2 + (h)) * HTB)
#define PG8_SB(b, h) ((4 + (b) * 2 + (h)) * HTB)
#define PG8_STAGE(bufoff, gbase, voff) do { _Pragma("unroll") for (int _i = 0; _i < 2; ++_i) \
        __builtin_amdgcn_global_load_lds((const unsigned*)((const char*)(gbase) + (voff)[_i]), (LAS unsigned*)(lds + (bufoff) + ldsw + _i * 8192), 16, 0, 0); } while (0)
#define PG8_LDA(dst, b, h) do { _Pragma("unroll") for (int m = 0; m < 4; ++m) _Pragma("unroll") for (int k = 0; k < 2; ++k) dst[m][k] = *(const LAS bf16x8*)(lds + PG8_SA(b, h) + aoff + m * 2048 + k * 1024); } while (0)
#define PG8_LDB(dst, b, h) do { _Pragma("unroll") for (int n = 0; n < 2; ++n) _Pragma("unroll") for (int k = 0; k < 2; ++k) dst[n][k] = *(const LAS bf16x8*)(lds + PG8_SB(b, h) + boff + n * 2048 + k * 1024); } while (0)
#define PG8_MMA(ai, bj, At, Bt) do { __builtin_amdgcn_s_setprio(1); _Pragma("unroll") for (int m = 0; m < 4; ++m) _Pragma("unroll") for (int n = 0; n < 2; ++n) _Pragma("unroll") for (int k = 0; k < 2; ++k) \
        acc[ai][bj][m][n] = __builtin_amdgcn_mfma_f32_16x16x32_bf16(Bt[n][k], At[m][k], acc[ai][bj][m][n], 0, 0, 0); __builtin_amdgcn_s_setprio(0); } while (0)
#define PG8_WAIT_V(n) asm volatile("s_waitcnt vmcnt(" #n ")" ::: "memory")
#define PG8_WAIT_L(n) asm volatile("s_waitcnt lgkmcnt(" #n ")" ::: "memory")
#define PG8_BAR __builtin_amdgcn_s_barrier()
#define PG8_SCHED __builtin_amdgcn_sched_barrier(0)
    Unit cur, nxt; int ui = 0;
    if (!S.next(0, cur)) return;
    f32x4 acc[2][2][4][2];
#pragma unroll
    for (int a = 0; a < 2; ++a)
#pragma unroll
        for (int b = 0; b < 2; ++b)
#pragma unroll
            for (int m = 0; m < 4; ++m)
#pragma unroll
                for (int n = 0; n < 2; ++n) acc[a][b][m][n] = (f32x4){0.f, 0.f, 0.f, 0.f};
    bf16x8 At[4][2], B0[2][2], B1[2][2];
    const char* cA = (const char*)g.A + (size_t)cur.pm * tstepA + (size_t)cur.pn * g.acol * 2 + (size_t)cur.k0 * 256; const char* cB = (const char*)g.Bt + (size_t)cur.pn * tstepB + (size_t)cur.k0 * 256;
    PG8_STAGE(PG8_SB(0, 0), cB, voffB); PG8_STAGE(PG8_SB(0, 1), cB + hstepB, voffB); PG8_STAGE(PG8_SA(0, 0), cA, voffA); PG8_STAGE(PG8_SA(0, 1), cA + hstepA, voffA);
    if (wr == 1) PG8_BAR;
    PG8_WAIT_V(2); PG8_BAR;
    PG8_STAGE(PG8_SB(1, 0), cB + kstep, voffB); PG8_STAGE(PG8_SA(1, 0), cA + kstep, voffA); PG8_STAGE(PG8_SB(1, 1), cB + hstepB + kstep, voffB);
    PG8_WAIT_V(6); PG8_BAR;
    for (;;) {
        const bool has_next = S.next(ui + 1, nxt);
        const char* nA = has_next ? (const char*)g.A + (size_t)nxt.pm * tstepA + (size_t)nxt.pn * g.acol * 2 + (size_t)nxt.k0 * 256 : cA; const char* nB = has_next ? (const char*)g.Bt + (size_t)nxt.pn * tstepB + (size_t)nxt.k0 * 256 : cB;
        const int nt = 2 * cur.np;
        for (int t = 0; t < nt; t += 2) {
            const bool last = (t == nt - 2);
            const char* a1 = cA + (size_t)(t + 1) * kstep;
            const char* a2 = last ? nA : cA + (size_t)(t + 2) * kstep; const char* b2 = last ? nB : cB + (size_t)(t + 2) * kstep;
            const char* a3 = a2 + kstep; const char* b3 = b2 + kstep;
            PG8_LDB(B0, 0, 0); PG8_LDB(B1, 0, 1); PG8_SCHED; PG8_LDA(At, 0, 0); PG8_STAGE(PG8_SA(1, 1), a1 + hstepA, voffA);
            PG8_WAIT_V(8); PG8_WAIT_L(0); PG8_BAR; PG8_MMA(0, 0, At, B0); PG8_MMA(0, 1, At, B1); PG8_BAR; PG8_SCHED;
            PG8_LDA(At, 0, 1); PG8_STAGE(PG8_SB(0, 0), b2, voffB); PG8_STAGE(PG8_SB(0, 1), b2 + hstepB, voffB); PG8_STAGE(PG8_SA(0, 0), a2, voffA);
            PG8_WAIT_V(8); PG8_WAIT_L(0); PG8_BAR; PG8_MMA(1, 0, At, B0); PG8_MMA(1, 1, At, B1); PG8_BAR; PG8_SCHED;
            PG8_LDB(B0, 1, 0); PG8_LDB(B1, 1, 1); PG8_SCHED; PG8_LDA(At, 1, 0); PG8_STAGE(PG8_SA(0, 1), a2 + hstepA, voffA);
            PG8_WAIT_V(8); PG8_WAIT_L(0); PG8_BAR; PG8_MMA(0, 0, At, B0); PG8_MMA(0, 1, At, B1); PG8_BAR; PG8_SCHED;
            PG8_LDA(At, 1, 1); PG8_STAGE(PG8_SB(1, 0), b3, voffB); PG8_STAGE(PG8_SB(1, 1), b3 + hstepB, voffB); PG8_STAGE(PG8_SA(1, 0), a3, voffA);
            PG8_WAIT_V(8); PG8_WAIT_L(0); PG8_BAR; PG8_MMA(1, 0, At, B0); PG8_MMA(1, 1, At, B1); PG8_BAR; PG8_SCHED;
        }
        if (wr == 0) PG8_BAR;
        E(acc, cur, wr, wc, fr, fq);
        if (!has_next) break;
#pragma unroll
        for (int a = 0; a < 2; ++a)
#pragma unroll
            for (int b = 0; b < 2; ++b)
#pragma unroll
                for (int m = 0; m < 4; ++m)
#pragma unroll
                    for (int n = 0; n < 2; ++n) acc[a][b][m][n] = (f32x4){0.f, 0.f, 0.f, 0.f};
        cur = nxt; cA = nA; cB = nB; ++ui;
        if (wr == 1) PG8_BAR;
    }
    PG8_WAIT_V(0);
    PG8_BAR;
#undef PG8_SA
#undef PG8_SB
#undef PG8_STAGE
#undef PG8_LDA
#undef PG8_LDB
#undef PG8_MMA
#undef PG8_WAIT_V
#undef PG8_WAIT_L
#undef PG8_BAR
#undef PG8_SCHED
}
}
using pg8::Unit;
struct EpiRes {
    static constexpr bool PERM = false;
    const float* base0; const float* base1; float* out; const float* scale; float* part; bool dry;
    DI void operator()(const f32x4 (&acc)[2][2][4][2], const Unit& u, int wr, int wc, int fr, int fq) const {
        const int col0 = u.pn * 256 + wc * 32 + 4 * fq;
        f32x4 sc[2][2];
#pragma unroll
        for (int bj = 0; bj < 2; ++bj)
#pragma unroll
            for (int n = 0; n < 2; ++n) sc[bj][n] = scale ? *(const f32x4*)(scale + col0 + bj * 128 + n * 16) : (f32x4){1.f, 1.f, 1.f, 1.f};
        if (u.pm >= 128) {
#pragma unroll
            for (int ai = 0; ai < 2; ++ai)
#pragma unroll
                for (int m = 0; m < 4; ++m) {
                    const int row = u.pm * 256 + ai * 128 + wr * 64 + m * 16 + fr;
                    float* pp = part + ((size_t)u.k0 * MS + (row - MP)) * D;
#pragma unroll
                    for (int bj = 0; bj < 2; ++bj)
#pragma unroll
                        for (int n = 0; n < 2; ++n) { const int c = col0 + bj * 128 + n * 16; if (!dry) *(f32x4*)(pp + c) = acc[ai][bj][m][n] * sc[bj][n]; }
                }
            return;
        }
#pragma unroll
        for (int ai = 0; ai < 2; ++ai) {
            f32x4 pre[4][2][2];
#pragma unroll
            for (int m = 0; m < 4; ++m) { const float* bp = base0 + (size_t)(u.pm * 256 + ai * 128 + wr * 64 + m * 16 + fr) * D;
#pragma unroll
                for (int bj = 0; bj < 2; ++bj)
#pragma unroll
                    for (int n = 0; n < 2; ++n) pre[m][bj][n] = *(const f32x4*)(bp + col0 + bj * 128 + n * 16); }
            asm volatile("" ::: "memory");
#pragma unroll
            for (int m = 0; m < 4; ++m) { float* op = out + (size_t)(u.pm * 256 + ai * 128 + wr * 64 + m * 16 + fr) * D;
#pragma unroll
                for (int bj = 0; bj < 2; ++bj)
#pragma unroll
                    for (int n = 0; n < 2; ++n) { if (!dry) *(f32x4*)(op + col0 + bj * 128 + n * 16) = pre[m][bj][n] + acc[ai][bj][m][n] * sc[bj][n]; } }
            asm volatile("" ::: "memory");
        }
    }
};
DI float dpp_ror1(float v) { return __int_as_float(__builtin_amdgcn_mov_dpp(__float_as_int(v), 0x121, 0xf, 0xf, false)); }
DI float dpp_ror2(float v) { return __int_as_float(__builtin_amdgcn_mov_dpp(__float_as_int(v), 0x122, 0xf, 0xf, false)); }
DI float silu_f(float y) { return y * __builtin_amdgcn_rcpf(1.f + __builtin_amdgcn_exp2f(-1.4426950408889634f * y)); }
struct EpiUp {
    static constexpr bool PERM = true;
    bf16_t* H; float* SG0; float* SV0; float* SGL; float* out; const float* cw; const float* cb; int layer; const float* st;
    DI void operator()(const f32x4 (&acc)[2][2][4][2], const Unit& u, int wr, int wc, int fr, int fq) const {
        const int col = u.pn * 128 + wc * 32 + 8 * fq;
        const bool smp = (u.pm >= 128);
        const V8 w0 = v8_ldf(cw + col), w1 = v8_ldf(cw + FF + col), w2 = v8_ldf(cw + 2 * FF + col), bb = v8_ldf(cb + col);
#pragma unroll
        for (int ai = 0; ai < 2; ++ai) {
            const int seg = u.pm * 4 + ai * 2 + wr;
            f32x4 q1[2], q2[2];
#pragma unroll
            for (int m = 0; m < 4; ++m) {
                const int row = seg * 64 + m * 16 + fr;
                f32x4 hh[2];
#pragma unroll
                for (int n = 0; n < 2; ++n) {
                    const f32x4 g = acc[ai][1][m][n], v = acc[ai][0][m][n];
                    f32x4 c1, c2;
#pragma unroll
                    for (int j = 0; j < 4; ++j) { c1[j] = dpp_ror1(g[j]); c2[j] = dpp_ror2(g[j]); }
                    f32x4 p1 = c1, p2 = c2;
                    if (m == 0 && smp) {
                        const float* sp = st + ((size_t)(seg - 512) * 2) * FF + col + 4 * n; const f32x4 s0 = *(const f32x4*)sp, s1 = *(const f32x4*)(sp + FF);
#pragma unroll
                        for (int j = 0; j < 4; ++j) { p1[j] = (fr == 0) ? s1[j] : c1[j]; p2[j] = (fr == 0) ? s0[j] : ((fr == 1) ? s1[j] : c2[j]); }
                    }
                    if (m > 0) {
#pragma unroll
                        for (int j = 0; j < 4; ++j) { p1[j] = (fr == 0) ? q1[n][j] : c1[j]; p2[j] = (fr < 2) ? q2[n][j] : c2[j]; }
                    }
                    q1[n] = c1; q2[n] = c2;
                    const f32x4 ww0 = n ? w0.b : w0.a, ww1 = n ? w1.b : w1.a, ww2 = n ? w2.b : w2.a, wb = n ? bb.b : bb.a;
                    const f32x4 y = ww0 * p2 + ww1 * p1 + ww2 * g + wb;
#pragma unroll
                    for (int j = 0; j < 4; ++j) hh[n][j] = silu_f(y[j]) * v[j];
                }
                if (m == 0 && fr < 2 && !smp) {
                    float* o = SG0 + ((size_t)seg * 2 + fr) * FF + col; *(f32x4*)o = acc[ai][1][m][0]; *(f32x4*)(o + 4) = acc[ai][1][m][1];
                    float* o2 = SV0 + ((size_t)seg * 2 + fr) * FF + col; *(f32x4*)o2 = acc[ai][0][m][0]; *(f32x4*)(o2 + 4) = acc[ai][0][m][1];
                } else {
                    u32x4 w; w.x = pk2(hh[0][0], hh[0][1]); w.y = pk2(hh[0][2], hh[0][3]); w.z = pk2(hh[1][0], hh[1][1]); w.w = pk2(hh[1][2], hh[1][3]);
                    *(u32x4*)(H + (size_t)row * FF + col) = w;
                }
                if (m == 3 && fr >= 14) {
                    float* o = SGL + ((size_t)seg * 2 + (fr - 14)) * FF + col; *(f32x4*)o = acc[ai][1][m][0]; *(f32x4*)(o + 4) = acc[ai][1][m][1];
                    int s, b, t; rowinfo(row, s, b, t); const int L = s ? 64 : 4096;
                    if (t >= L - 2) { float* os = out + (s ? O_FFNS : O_FFNP) + ((size_t)(layer * 8 + b) * 2 + (t - (L - 2))) * FF + col; *(f32x4*)os = acc[ai][1][m][0]; *(f32x4*)(os + 4) = acc[ai][1][m][1]; }
                }
            }
        }
    }
};
struct EpiDnIn {
    static constexpr bool PERM = true;
    bf16_t* PRE; bf16_t* Z; float* AB; bf16_t* HALO; float* out;
    DI void operator()(const f32x4 (&acc)[2][2][4][2], const Unit& u, int wr, int wc, int fr, int fq) const {
#pragma unroll
        for (int ai = 0; ai < 2; ++ai)
#pragma unroll
            for (int m = 0; m < 4; ++m) {
                const int row = u.pm * 256 + ai * 128 + wr * 64 + m * 16 + fr;
                int s, b, t; rowinfo(row, s, b, t); const int L = s ? 64 : 4096;
#pragma unroll
                for (int bj = 0; bj < 2; ++bj) {
                    const int col = u.pn * 256 + bj * 128 + wc * 32 + 8 * fq;
                    u32x4 w; w.x = pk2(acc[ai][bj][m][0][0], acc[ai][bj][m][0][1]); w.y = pk2(acc[ai][bj][m][0][2], acc[ai][bj][m][0][3]); w.z = pk2(acc[ai][bj][m][1][0], acc[ai][bj][m][1][1]); w.w = pk2(acc[ai][bj][m][1][2], acc[ai][bj][m][1][3]);
                    if (u.pn < 12) {
                        *(u32x4*)(PRE + (size_t)row * DNQ + col) = w;
                        if ((t & 63) >= 61) *(u32x4*)(HALO + ((size_t)(row >> 6) * 3 + ((t & 63) - 61)) * DNQ + col) = w;
                        if (t >= L - 3) { float* o = out + (s ? O_DNCS : O_DNCP) + ((size_t)b * 3 + (t - (L - 3))) * DNQ + col; *(f32x4*)o = acc[ai][bj][m][0]; *(f32x4*)(o + 4) = acc[ai][bj][m][1]; }
                    } else if (u.pn < 16) {
                        *(u32x4*)(Z + (size_t)row * D + (col - DNQ)) = w;
                    } else if (bj == 0 && wc == 0 && fq < 2) {
                        float* o = AB + (size_t)row * 16 + 8 * fq; *(f32x4*)o = acc[ai][bj][m][0]; *(f32x4*)(o + 4) = acc[ai][bj][m][1];
                    }
                }
            }
    }
};
struct EpiQkv {
    static constexpr bool PERM = true;
    bf16_t* Q; bf16_t* KP; bf16_t* VTP; bf16_t* KS; bf16_t* VTS; float* out; LAS unsigned char* tl;
    DI void operator()(const f32x4 (&acc)[2][2][4][2], const Unit& u, int wr, int wc, int fr, int fq) const {
        LAS unsigned char* tw = tl + (wr * 4 + wc) * 1024; const int lane = fq * 16 + fr;
#pragma unroll
        for (int ai = 0; ai < 2; ++ai)
#pragma unroll
            for (int m = 0; m < 4; ++m) {
                const int row = u.pm * 256 + ai * 128 + wr * 64 + m * 16 + fr;
                int s, b, t; rowinfo(row, s, b, t);
#pragma unroll
                for (int bj = 0; bj < 2; ++bj) {
                    const int col = u.pn * 256 + bj * 128 + wc * 32 + 8 * fq;
                    u32x4 w; w.x = pk2(acc[ai][bj][m][0][0], acc[ai][bj][m][0][1]); w.y = pk2(acc[ai][bj][m][0][2], acc[ai][bj][m][0][3]); w.z = pk2(acc[ai][bj][m][1][0], acc[ai][bj][m][1][1]); w.w = pk2(acc[ai][bj][m][1][2], acc[ai][bj][m][1][3]);
                    if (u.pn < 4) { *(u32x4*)(Q + (size_t)row * D + col) = w; }
                    else if (u.pn < 8) {
                        const int c = col - D;
                        float* o = out + (s ? O_KS + (size_t)(row - MP) * D : O_KP + (size_t)row * D) + c; __builtin_nontemporal_store(acc[ai][bj][m][0], (f32x4*)o); __builtin_nontemporal_store(acc[ai][bj][m][1], (f32x4*)(o + 4));
                        bf16_t* kb = s ? KS + ((size_t)b * LK + PAST + t) * D + c : KP + (size_t)row * D + c; *(u32x4*)kb = w;
                    } else {
                        const int c = col - 2 * D;
                        float* o = out + (s ? O_VS + (size_t)(row - MP) * D : O_VP + (size_t)row * D) + c; __builtin_nontemporal_store(acc[ai][bj][m][0], (f32x4*)o); __builtin_nontemporal_store(acc[ai][bj][m][1], (f32x4*)(o + 4));
                        LAS bf16_t* tp = (LAS bf16_t*)tw + (8 * fq) * 16 + fr;
                        tp[0] = (bf16_t)(w.x & 0xffff); tp[16] = (bf16_t)(w.x >> 16); tp[32] = (bf16_t)(w.y & 0xffff); tp[48] = (bf16_t)(w.y >> 16);
                        tp[64] = (bf16_t)(w.z & 0xffff); tp[80] = (bf16_t)(w.z >> 16); tp[96] = (bf16_t)(w.w & 0xffff); tp[112] = (bf16_t)(w.w >> 16);
                        asm volatile("s_waitcnt lgkmcnt(0)" ::: "memory");
                        const u32x4 tv = *(const LAS u32x4*)(tw + (lane >> 1) * 32 + (lane & 1) * 16);
                        asm volatile("s_waitcnt lgkmcnt(0)" ::: "memory");
                        const int cc = (col - 8 * fq) - 2 * D + (lane >> 1), h = cc >> 6, d = cc & 63, t0 = (t - fr) + (lane & 1) * 8;
                        bf16_t* vt = s ? VTS + ((size_t)(b * 16 + h) * 64 + d) * LK + PAST + t0 : VTP + ((size_t)(b * 16 + h) * 64 + d) * 4096 + t0;
                        *(u32x4*)vt = tv;
                    }
                }
            }
    }
};

DI void cvt_item(const float* W, int ldw, int nvalid, int srccol0, bf16_t* WT, int K, int dstrow0, int k0, LAS float* scr, int lane) {
    const int n = srccol0 + (lane & 31);
#pragma unroll 8
    for (int i = 0; i < 32; ++i) { const int kk = 2 * i + (lane >> 5); scr[kk * 33 + (lane & 31)] = (n < nvalid) ? W[(size_t)(k0 + kk) * ldw + n] : 0.f; }
    asm volatile("s_waitcnt lgkmcnt(0)" ::: "memory");
    const int c = lane & 7;
#pragma unroll
    for (int j = 0; j < 4; ++j) { const int nn = (lane >> 3) + 8 * j; const LAS float* s = scr + (8 * c) * 33 + nn;
        u32x4 o; o.x = pk2(s[0 * 33], s[1 * 33]); o.y = pk2(s[2 * 33], s[3 * 33]); o.z = pk2(s[4 * 33], s[5 * 33]); o.w = pk2(s[6 * 33], s[7 * 33]);
        *(u32x4*)(WT + (size_t)(dstrow0 + nn) * K + k0 + 8 * c) = o; }
    asm volatile("s_waitcnt lgkmcnt(0)" ::: "memory");
}
template <int MODE>
DI void cvt_matrix(const float* W, int ldw, int nvalid, int K, int Npad, bf16_t* WT, LAS float* scr, int gw, int NGW, int lane) {
    const int nblk = Npad / 32, nitems = (K / 64) * nblk;
    for (int it = gw; it < nitems; it += NGW) {
        const int kb = it / nblk, nb = it % nblk; int src0 = nb * 32;
        if (MODE == 1) { const int pn = nb >> 3, wb = nb & 7; src0 = (wb < 4) ? pn * 128 + wb * 32 : FF + pn * 128 + (wb - 4) * 32; }
        cvt_item(W, ldw, nvalid, src0, WT, K, nb * 32, kb * 64, scr, lane);
    }
}

DI void convert_layer_weights(const Params& p, int layer, LAS float* scr, int gw, int NGW, int lane) {
    cvt_matrix<1>(p.in[21] + (size_t)layer * D * NUP, NUP, NUP, D, NUP, (bf16_t*)(p.ws + w_up(layer)), scr, gw, NGW, lane);
    cvt_matrix<0>(p.in[24] + (size_t)layer * FF * D, D, D, FF, D, (bf16_t*)(p.ws + w_dn(layer)), scr, gw, NGW, lane);
    if (layer == 0 || layer == 3) {
        for (int g = 0; g < 4; ++g) cvt_matrix<0>(p.in[11] + (size_t)((layer / 3) * 4 + g) * 65536, 256, 256, 256, 256, (bf16_t*)(p.ws + w_mix(layer)) + (size_t)g * 65536, scr, gw, NGW, lane);
    } else if (layer == 1) {
        cvt_matrix<0>(p.in[13], DNIN, DNIN, D, DNINP, (bf16_t*)(p.ws + w_mix(1)), scr, gw, NGW, lane);
        cvt_matrix<0>(p.in[18], D, D, D, D, (bf16_t*)(p.ws + w_mix2(1)), scr, gw, NGW, lane);
    } else {
        cvt_matrix<0>(p.in[19], 3 * D, 3 * D, D, 3 * D, (bf16_t*)(p.ws + w_mix(2)), scr, gw, NGW, lane);
        cvt_matrix<0>(p.in[20], D, D, D, D, (bf16_t*)(p.ws + w_mix2(2)), scr, gw, NGW, lane);
    }
}

template <bool FINAL>
DI void norm_rows(const Params& p, const float* gain, int in_mode  , int npart  , int pool_j  , int gw, int NGW, int lane) {
    float* X = p.out; bf16_t* XN = (bf16_t*)(p.ws + WS_XN);
    f32x4 gv[4];
#pragma unroll
    for (int j = 0; j < 4; ++j) gv[j] = *(const f32x4*)(gain + 4 * lane + 256 * j);
    for (int row = gw; row < MA; row += NGW) {
        const float* xr = (row < MP) ? (in_mode == 1 ? p.in[0] + (size_t)row * D : X + (size_t)row * D) : (in_mode ? p.in[1] + (size_t)(row - MP) * D : X + (size_t)row * D);
        f32x4 v[4]; float s = 0.f;
#pragma unroll
        for (int j = 0; j < 4; ++j) v[j] = *(const f32x4*)(xr + 4 * lane + 256 * j);
        if (row >= MP && npart > 0) {
            const float* pp = (const float*)(p.ws + WS_PART) + (size_t)(row - MP) * D + 4 * lane;
            int k = 0;
            for (; k + 4 <= npart; k += 4) {
                f32x4 t[4][4];
#pragma unroll
                for (int kk = 0; kk < 4; ++kk)
#pragma unroll
                    for (int j = 0; j < 4; ++j) t[kk][j] = *(const f32x4*)(pp + (size_t)(k + kk) * MS * D + 256 * j);
#pragma unroll
                for (int j = 0; j < 4; ++j) v[j] += (t[0][j] + t[1][j]) + (t[2][j] + t[3][j]);
            }
            for (; k + 2 <= npart; k += 2) {
                f32x4 t[2][4];
#pragma unroll
                for (int kk = 0; kk < 2; ++kk)
#pragma unroll
                    for (int j = 0; j < 4; ++j) t[kk][j] = *(const f32x4*)(pp + (size_t)(k + kk) * MS * D + 256 * j);
#pragma unroll
                for (int j = 0; j < 4; ++j) v[j] += t[0][j] + t[1][j];
            }
            if (!FINAL) {
#pragma unroll
                for (int j = 0; j < 4; ++j) *(f32x4*)(X + (size_t)row * D + 4 * lane + 256 * j) = v[j]; }
        }
#pragma unroll
        for (int j = 0; j < 4; ++j) { s += (v[j].x * v[j].x + v[j].y * v[j].y) + (v[j].z * v[j].z + v[j].w * v[j].w); }
        const float rstd = rsqrtf(wave_sum(s) * (1.f / D) + EPS);
#pragma unroll
        for (int j = 0; j < 4; ++j) v[j] = v[j] * rstd * gv[j];
        if (FINAL) {
#pragma unroll
            for (int j = 0; j < 4; ++j) __builtin_nontemporal_store(v[j], (f32x4*)(X + (size_t)row * D + 4 * lane + 256 * j));
        } else {
#pragma unroll
            for (int j = 0; j < 4; ++j) { u32x2 w; w.x = pk2(v[j].x, v[j].y); w.y = pk2(v[j].z, v[j].w); *(u32x2*)(XN + (size_t)row * D + 4 * lane + 256 * j) = w; }
            if (pool_j >= 0) { int s2, b, t; rowinfo(row, s2, b, t); const int L = s2 ? 64 : 4096;
                if (t >= L - 15) { float* o = p.out + (s2 ? O_POOLS : O_POOLP) + ((size_t)(pool_j * 8 + b) * 15 + (t - (L - 15))) * D;
#pragma unroll
                    for (int j = 0; j < 4; ++j) *(f32x4*)(o + 4 * lane + 256 * j) = v[j]; } }
        }
    }
}

DI void sb_cache_convert(const Params& p, LAS float* scr  , int gtid, int NT, int gw, int NGW, int lane) {
    const float* ck = p.in[5]; const float* cv = p.in[6];
    bf16_t* KS = (bf16_t*)(p.ws + WS_KS); bf16_t* VTS = (bf16_t*)(p.ws + WS_VTS);
    for (int it = gtid; it < 8 * PAST * D / 8; it += NT) { const int c8 = it & 127, rp = it >> 7, b = rp >> 11, pos = rp & 2047;
        const V8 v = v8_ldf(ck + (size_t)rp * D + c8 * 8); *(u32x4*)(KS + ((size_t)b * LK + pos) * D + c8 * 8) = v8_pack(v); }
    for (int it = gw; it < 8 * 16 * 32; it += NGW) { const int pb = it & 31, h = (it >> 5) & 15, b = it >> 9, p0 = pb * 64;
#pragma unroll 8
        for (int i = 0; i < 64; ++i) scr[i * 65 + lane] = cv[((size_t)b * PAST + p0 + i) * D + h * 64 + lane];
        asm volatile("s_waitcnt lgkmcnt(0)" ::: "memory");
        bf16_t* dst = VTS + ((size_t)(b * 16 + h) * 64 + lane) * LK + p0;
#pragma unroll
        for (int c = 0; c < 8; ++c) { const LAS float* s = scr + (8 * c) * 65 + lane; u32x4 o; o.x = pk2(s[0], s[65]); o.y = pk2(s[130], s[195]); o.z = pk2(s[260], s[325]); o.w = pk2(s[390], s[455]); *(u32x4*)(dst + 8 * c) = o; }
        asm volatile("s_waitcnt lgkmcnt(0)" ::: "memory");
    }
}

DI void pool_diff(const Params& p, int pool_j, int gtid, int NT) {
    const bf16_t* XN = (const bf16_t*)(p.ws + WS_XN); bf16_t* Dd = (bf16_t*)(p.ws + WS_BIG);
    const float* sp = p.in[2] + (size_t)pool_j * 8 * 15 * D;
    for (int it = gtid; it < (MA / 32) * 128; it += NT) {
        const int cgp = it & 127, strip = it >> 7, row0 = strip * 32, c0 = cgp * 8, win = 2 << (c0 >> 8);
        int s, b, t0; rowinfo(row0, s, b, t0);
        const size_t seq0 = (size_t)(row0 - t0);
        V8 sum = v8zero();
#define POOL_LD(tt, dst) do { const int _t = (tt); if (_t >= 0) dst = v8_ldbf(XN + (seq0 + _t) * D + c0); else if (s) dst = v8_ldf(sp + ((size_t)b * 15 + 15 + _t) * D + c0); else dst = v8zero(); } while (0)
        for (int j = win - 1; j >= 1; --j) { V8 v; POOL_LD(t0 - j, v); sum.a += v.a; sum.b += v.b; }
        for (int r = 0; r < 32; ++r) {
            const int t = t0 + r; V8 cur; POOL_LD(t, cur); sum.a += cur.a; sum.b += cur.b;
            const float cnt = s ? (float)win : (float)((t + 1) < win ? (t + 1) : win); const float inv = 1.f / cnt;
            V8 d; d.a = sum.a * inv - cur.a; d.b = sum.b * inv - cur.b;
            *(u32x4*)(Dd + (size_t)(row0 + r) * D + c0) = v8_pack(d);
            V8 old; POOL_LD(t - win + 1, old); sum.a -= old.a; sum.b -= old.b;
        }
#undef POOL_LD
    }
}

DI void ffn_hidden(const Params& p, int layer, int gtid, int NT) {
    bf16_t* H = (bf16_t*)(p.ws + WS_V); const float* SG0 = (const float*)(p.ws + WS_SG0); const float* SV0 = (const float*)(p.ws + WS_SV0); const float* SGL = (const float*)(p.ws + WS_SGL);
    const float* cw = p.in[22] + (size_t)layer * 3 * FF; const float* cb = p.in[23] + (size_t)layer * FF; const float* st = p.in[7] + (size_t)layer * 8 * 2 * FF;
    for (int it = gtid; it < 512 * 352; it += NT) {
        const int cgp = it % 352, seg = it / 352, row0 = seg * 64, c0 = cgp * 8;
        int s, b, t0; rowinfo(row0, s, b, t0);
        const V8 w0 = v8_ldf(cw + c0), w1 = v8_ldf(cw + FF + c0), w2 = v8_ldf(cw + 2 * FF + c0), bb = v8_ldf(cb + c0);
        V8 g2, g1;
        if (t0 == 0) { if (s) { g2 = v8_ldf(st + ((size_t)b * 2 + 0) * FF + c0); g1 = v8_ldf(st + ((size_t)b * 2 + 1) * FF + c0); } else { g2 = v8zero(); g1 = v8zero(); } }
        else { g2 = v8_ldf(SGL + ((size_t)(seg - 1) * 2 + 0) * FF + c0); g1 = v8_ldf(SGL + ((size_t)(seg - 1) * 2 + 1) * FF + c0); }
#pragma unroll
        for (int r = 0; r < 2; ++r) {
            const V8 g0 = v8_ldf(SG0 + ((size_t)seg * 2 + r) * FF + c0); const V8 v = v8_ldf(SV0 + ((size_t)seg * 2 + r) * FF + c0);
            V8 y; y.a = w0.a * g2.a + w1.a * g1.a + w2.a * g0.a + bb.a; y.b = w0.b * g2.b + w1.b * g1.b + w2.b * g0.b + bb.b;
            V8 h;
#pragma unroll
            for (int e = 0; e < 4; ++e) { h.a[e] = silu_f(y.a[e]) * v.a[e]; h.b[e] = silu_f(y.b[e]) * v.b[e]; }
            *(u32x4*)(H + (size_t)(row0 + r) * FF + c0) = v8_pack(h);
            g2 = g1; g1 = g0;
        }
    }
}

DI void lds_barrier() { asm volatile("s_waitcnt lgkmcnt(0)" ::: "memory"); __builtin_amdgcn_s_barrier(); asm volatile("" ::: "memory"); }
constexpr int DN_MST = 68, DN_RST = 260;
constexpr int DN_MM = 0, DN_QS = 17408, DN_KS = 34816, DN_KBS = 52224, DN_RHS = 69632, DN_GC = 136192, DN_BETA = 136448, DN_CW = 136704;
DI void dn_intra(const Params& p, LAS unsigned char* L, int tid_in, int wave, int bid, int G, bool dry) {
    bf16_t* PRE = (bf16_t*)(p.ws + WS_PRE); bf16_t* Wb = (bf16_t*)(p.ws + WS_W); bf16_t* ATT = (bf16_t*)(p.out + O_VP);
    const bf16_t* HALO = (const bf16_t*)(p.ws + WS_HALO); const float* AB = (const float*)(p.ws + WS_AB); float* GL = (float*)(p.ws + WS_GL);
    const float* convw = p.in[14]; const float* stc = p.in[3];
    LAS float* gcs = (LAS float*)(L + DN_GC); LAS float* betas = (LAS float*)(L + DN_BETA);
    LAS float* Mm = (LAS float*)(L + DN_MM); LAS float* RHS = (LAS float*)(L + DN_RHS);
    const int h = bid & 7, ngrp = (G >> 3) > 0 ? (G >> 3) : 1;
    LAS float* CW = (LAS float*)(L + DN_CW);
    for (int i = tid_in; i < 4 * 384; i += 512) { const int j = i / 384, c = i % 384; CW[i] = convw[(size_t)j * DNQ + (c >> 7) * 1024 + h * 128 + (c & 127)]; }
    lds_barrier();
#define DN_PREFETCH(SEGX, TID) do { const int seg_ = (SEGX), row0_ = seg_ * 64; int s_, b_, t0_; rowinfo(row0_, s_, b_, t0_); const int r_ = (TID) >> 3, sub_ = (TID) & 7; \
        _Pragma("unroll") for (int part = 0; part < 3; ++part) { const int col = part * 1024 + h * 128 + sub_ * 16; \
            _Pragma("unroll") for (int j = 0; j < 4; ++j) { const int rr = r_ - 3 + j; \
                if (rr >= 0) { const bf16_t* q = PRE + (size_t)(row0_ + rr) * DNQ + col; xr[part][j][0] = *(const u32x4*)q; xr[part][j][1] = *(const u32x4*)(q + 8); } \
                else if (t0_ != 0) { const bf16_t* q = HALO + ((size_t)(seg_ - 1) * 3 + (3 + rr)) * DNQ + col; xr[part][j][0] = *(const u32x4*)q; xr[part][j][1] = *(const u32x4*)(q + 8); } \
                else if (s_) { const float* q = stc + ((size_t)b_ * 3 + (3 + rr)) * DNQ + col; xr[part][j][0] = v8_pack(v8_ldf(q)); xr[part][j][1] = v8_pack(v8_ldf(q + 8)); } \
                else { xr[part][j][0] = (u32x4){0u, 0u, 0u, 0u}; xr[part][j][1] = (u32x4){0u, 0u, 0u, 0u}; } } } } while (0)
    u32x4 xr[3][4][2];
    if ((bid >> 3) < NSEG) DN_PREFETCH(bid >> 3, tid_in);
    for (int seg = (bid >> 3); seg < NSEG; seg += ngrp) {
        if ((G >> 3) == 0 && (bid != 0)) break;
        const int u = seg * 8 + h, row0 = seg * 64;
        int s, b, t0; rowinfo(row0, s, b, t0);
        int tid = tid_in; asm volatile("" : "+v"(tid)); int lane = tid & 63;
        const int r = tid >> 3, sub = tid & 7;
        if (wave == 0) {
            const float a = AB[(size_t)(row0 + lane) * 16 + h], bq = AB[(size_t)(row0 + lane) * 16 + 8 + h];
            const float beta = 1.f / (1.f + expf(-bq));
            const float x = a + p.in[16][h]; const float spx = fmaxf(x, 0.f) + log1pf(expf(-fabsf(x)));
            float g = -expf(p.in[15][h]) * spx;
#pragma unroll
            for (int o = 1; o < 64; o <<= 1) { const float v = __shfl_up(g, o); if (lane >= o) g += v; }
            gcs[lane] = g; betas[lane] = beta;
        }
        float qv[16], kv[16], vv[16]; float rq = 0.f, rk = 0.f;
#pragma unroll
        for (int part = 0; part < 3; ++part) {
            float y[16];
#pragma unroll
            for (int e = 0; e < 16; ++e) y[e] = 0.f;
#pragma unroll
            for (int j = 0; j < 4; ++j) {
                const V8 x0 = v8_from_bf(xr[part][j][0]), x1 = v8_from_bf(xr[part][j][1]);
                const LAS float* wq = CW + j * 384 + part * 128 + sub * 16;
                const f32x4 wa = *(const LAS f32x4*)wq, wb = *(const LAS f32x4*)(wq + 4), wc = *(const LAS f32x4*)(wq + 8), wd = *(const LAS f32x4*)(wq + 12);
#pragma unroll
                for (int e = 0; e < 4; ++e) { y[e] += wa[e] * x0.a[e]; y[4 + e] += wb[e] * x0.b[e]; y[8 + e] += wc[e] * x1.a[e]; y[12 + e] += wd[e] * x1.b[e]; }
            }
            float ss = 0.f;
#pragma unroll
            for (int e = 0; e < 16; ++e) { y[e] = silu_f(y[e]); ss += y[e] * y[e]; }
            if (part < 2) { ss += __shfl_xor(ss, 1); ss += __shfl_xor(ss, 2); ss += __shfl_xor(ss, 4); }
            if (part == 0) { rq = rsqrtf(ss + EPS) * 0.08838834764831845f;
#pragma unroll
                for (int e = 0; e < 16; ++e) qv[e] = y[e] * rq; }
            else if (part == 1) { rk = rsqrtf(ss + EPS);
#pragma unroll
                for (int e = 0; e < 16; ++e) kv[e] = y[e] * rk; }
            else {
#pragma unroll
                for (int e = 0; e < 16; ++e) vv[e] = y[e]; }
        }
        lds_barrier();
        const float beta = betas[r], gcr = gcs[r], gl = gcs[63];
        { u32x4 w0, w1; w0.x = pk2(qv[0], qv[1]); w0.y = pk2(qv[2], qv[3]); w0.z = pk2(qv[4], qv[5]); w0.w = pk2(qv[6], qv[7]); w1.x = pk2(qv[8], qv[9]); w1.y = pk2(qv[10], qv[11]); w1.z = pk2(qv[12], qv[13]); w1.w = pk2(qv[14], qv[15]);
          *(LAS u32x4*)(L + DN_QS + r * 272 + sub * 32) = w0; *(LAS u32x4*)(L + DN_QS + r * 272 + sub * 32 + 16) = w1;
          w0.x = pk2(kv[0], kv[1]); w0.y = pk2(kv[2], kv[3]); w0.z = pk2(kv[4], kv[5]); w0.w = pk2(kv[6], kv[7]); w1.x = pk2(kv[8], kv[9]); w1.y = pk2(kv[10], kv[11]); w1.z = pk2(kv[12], kv[13]); w1.w = pk2(kv[14], kv[15]);
          *(LAS u32x4*)(L + DN_KS + r * 272 + sub * 32) = w0; *(LAS u32x4*)(L + DN_KS + r * 272 + sub * 32 + 16) = w1;
          w0.x = pk2(kv[0] * beta, kv[1] * beta); w0.y = pk2(kv[2] * beta, kv[3] * beta); w0.z = pk2(kv[4] * beta, kv[5] * beta); w0.w = pk2(kv[6] * beta, kv[7] * beta);
          w1.x = pk2(kv[8] * beta, kv[9] * beta); w1.y = pk2(kv[10] * beta, kv[11] * beta); w1.z = pk2(kv[12] * beta, kv[13] * beta); w1.w = pk2(kv[14] * beta, kv[15] * beta);
          *(LAS u32x4*)(L + DN_KBS + r * 272 + sub * 32) = w0; *(LAS u32x4*)(L + DN_KBS + r * 272 + sub * 32 + 16) = w1;
          const float kb = beta * __expf(gcr);
#pragma unroll
          for (int e4 = 0; e4 < 4; ++e4) { *(LAS f32x4*)(RHS + r * DN_RST + 128 + sub * 16 + e4 * 4) = (f32x4){kv[4 * e4] * kb, kv[4 * e4 + 1] * kb, kv[4 * e4 + 2] * kb, kv[4 * e4 + 3] * kb};
              *(LAS f32x4*)(RHS + r * DN_RST + sub * 16 + e4 * 4) = (f32x4){vv[4 * e4] * beta, vv[4 * e4 + 1] * beta, vv[4 * e4 + 2] * beta, vv[4 * e4 + 3] * beta}; } }
        lds_barrier();
        asm volatile("" : "+v"(tid)); lane = tid & 63;
        { const float eq = __expf(gcr), ek = __expf(gl - gcr);
          u32x4 w0, w1; w0.x = pk2(qv[0] * eq, qv[1] * eq); w0.y = pk2(qv[2] * eq, qv[3] * eq); w0.z = pk2(qv[4] * eq, qv[5] * eq); w0.w = pk2(qv[6] * eq, qv[7] * eq);
          w1.x = pk2(qv[8] * eq, qv[9] * eq); w1.y = pk2(qv[10] * eq, qv[11] * eq); w1.z = pk2(qv[12] * eq, qv[13] * eq); w1.w = pk2(qv[14] * eq, qv[15] * eq);
          bf16_t* q = PRE + (size_t)(row0 + r) * DNQ + h * 128 + sub * 16; if (!dry) { *(u32x4*)q = w0; *(u32x4*)(q + 8) = w1; }
          w0.x = pk2(kv[0] * ek, kv[1] * ek); w0.y = pk2(kv[2] * ek, kv[3] * ek); w0.z = pk2(kv[4] * ek, kv[5] * ek); w0.w = pk2(kv[6] * ek, kv[7] * ek);
          w1.x = pk2(kv[8] * ek, kv[9] * ek); w1.y = pk2(kv[10] * ek, kv[11] * ek); w1.z = pk2(kv[12] * ek, kv[13] * ek); w1.w = pk2(kv[14] * ek, kv[15] * ek);
          if (!dry) { *(u32x4*)(q + 1024) = w0; *(u32x4*)(q + 1024 + 8) = w1; }
          if (tid == 0) GL[u] = __expf(gl); }
        asm volatile("" : "+v"(tid)); lane = tid & 63;
        { const int which = wave >> 2, blk = wave & 3, ib = blk >> 1, jb = blk & 1, n31 = lane & 31, hi = lane >> 5;
          f32x16 c;
#pragma unroll
          for (int e = 0; e < 16; ++e) c[e] = 0.f;
          if (!(ib == 0 && jb == 1)) {
              const int abase = (which ? DN_QS : DN_KBS) + (ib * 32 + n31) * 272 + hi * 16, bbase = DN_KS + (jb * 32 + n31) * 272 + hi * 16;
#pragma unroll
              for (int ks = 0; ks < 8; ++ks) { const bf16x8 a = *(const LAS bf16x8*)(L + abase + ks * 32); const bf16x8 bb = *(const LAS bf16x8*)(L + bbase + ks * 32); c = MFMA32(a, bb, c); }
          }
          const int j = jb * 32 + n31; const float gj = gcs[j];
#pragma unroll
          for (int e = 0; e < 16; ++e) { const int i = ib * 32 + crow(e, hi); const float dec = __expf(gcs[i] - gj);
              if (which == 0) Mm[i * DN_MST + j] = (i > j) ? c[e] * dec : 0.f;
              else if (!dry) ATT[(size_t)u * 4096 + i * 64 + j] = f2bf((i >= j) ? c[e] * dec : 0.f); }
        }
        lds_barrier();
        asm volatile("" : "+v"(tid)); lane = tid & 63;
        asm volatile("" : "+v"(tid));
        if (seg + ngrp < NSEG) DN_PREFETCH(seg + ngrp, tid);
        if (tid < 256) {
            float x[32];
#pragma unroll
            for (int i = 0; i < 32; ++i) {
                float a = RHS[i * DN_RST + tid];
#pragma unroll
                for (int j4 = 0; j4 < (i + 3) / 4; ++j4) { const f32x4 m4 = *(const LAS f32x4*)(Mm + i * DN_MST + 4 * j4);
#pragma unroll
                    for (int e = 0; e < 4; ++e) if (4 * j4 + e < i) a -= m4[e] * x[4 * j4 + e]; }
                x[i] = a; RHS[i * DN_RST + tid] = a; if ((i & 1) == 1) __builtin_amdgcn_sched_barrier(0);
            }
        }
        lds_barrier();
        { asm volatile("" : "+v"(tid)); lane = tid & 63; const int n31 = lane & 31, hi = lane >> 5;
          f32x16 c;
#pragma unroll
          for (int e = 0; e < 16; ++e) c[e] = 0.f;
#pragma unroll
          for (int ks = 0; ks < 16; ++ks) { const float av = Mm[(32 + n31) * DN_MST + 2 * ks + hi]; const float bv = RHS[(2 * ks + hi) * DN_RST + wave * 32 + n31]; c = __builtin_amdgcn_mfma_f32_32x32x2f32(av, bv, c, 0, 0, 0); }
#pragma unroll
          for (int e = 0; e < 16; ++e) { LAS float* q = RHS + (32 + crow(e, hi)) * DN_RST + wave * 32 + n31; *q = *q - c[e]; } }
        lds_barrier();
        asm volatile("" : "+v"(tid)); lane = tid & 63;
        if (tid < 256) {
            float x[32];
#pragma unroll
            for (int i = 0; i < 32; ++i) {
                float a = RHS[(32 + i) * DN_RST + tid];
#pragma unroll
                for (int j4 = 0; j4 < (i + 3) / 4; ++j4) { const f32x4 m4 = *(const LAS f32x4*)(Mm + (32 + i) * DN_MST + 32 + 4 * j4);
#pragma unroll
                    for (int e = 0; e < 4; ++e) if (4 * j4 + e < i) a -= m4[e] * x[4 * j4 + e]; }
                x[i] = a; RHS[(32 + i) * DN_RST + tid] = a; if ((i & 1) == 1) __builtin_amdgcn_sched_barrier(0);
            }
        }
        lds_barrier();
        asm volatile("" : "+v"(tid));
        for (int it = tid; it < 64 * 32; it += 512) {
            const int i = it >> 5, c8 = it & 31;
            const f32x4 a = *(const LAS f32x4*)(RHS + i * DN_RST + c8 * 8), bq = *(const LAS f32x4*)(RHS + i * DN_RST + c8 * 8 + 4);
            u32x4 w;
            if (dry) continue;
            if (c8 < 16) { w.x = pk2(a.x, a.y); w.y = pk2(a.z, a.w); w.z = pk2(bq.x, bq.y); w.w = pk2(bq.z, bq.w); *(u32x4*)(PRE + (size_t)(row0 + i) * DNQ + 2048 + h * 128 + c8 * 8) = w; }
            else { w.x = pk2(-a.x, -a.y); w.y = pk2(-a.z, -a.w); w.z = pk2(-bq.x, -bq.y); w.w = pk2(-bq.z, -bq.w); *(u32x4*)(Wb + (size_t)(row0 + i) * D + h * 128 + (c8 - 16) * 8) = w; }
        }
        lds_barrier();
    }
}

constexpr int SC_W = 0, SC_QG = 17408, SC_AT = 34816, SC_KGT = 44032, SC_U = 62464, SC_ST = 79872, SC_VNT = 114688;
DI void dn_scan(const Params& p, LAS unsigned char* L, int tid, int wave, int lane, int bid, int G) {
    const int w = bid;
    if (w >= 128) {
        if (G > 128) { LAS float* scr = (LAS float*)(L + wave * 16640); const int gw2 = (w - 128) * 8 + wave, NGW2 = (G - 128) * 8;
            convert_layer_weights(p, 2, scr, gw2, NGW2, lane); convert_layer_weights(p, 3, scr, gw2, NGW2, lane);
            sb_cache_convert(p, scr, (w - 128) * 512 + tid, (G - 128) * 512, gw2, NGW2, lane); }
        return;
    }
    const int strm = w >> 6, b = (w & 63) >> 3, h = w & 7, nsteps = strm ? 1 : 64, seg0 = strm ? 512 + b : b * 64;
    const bf16_t* PRE = (const bf16_t*)(p.ws + WS_PRE); const bf16_t* Wb = (const bf16_t*)(p.ws + WS_W); const bf16_t* ATT = (const bf16_t*)(p.out + O_VP); const float* GL = (const float*)(p.ws + WS_GL); bf16_t* XNo = (bf16_t*)(p.ws + WS_XN);
    const int n31 = lane & 31, hi = lane >> 5, ib = wave >> 2, db = wave & 3;
    f32x16 sacc[2];
    { const float* S0 = p.in[4] + (size_t)(b * 8 + h) * 16384;
#pragma unroll
      for (int k2 = 0; k2 < 2; ++k2) { const int kb = ib * 2 + k2;
#pragma unroll
          for (int e = 0; e < 16; ++e) sacc[k2][e] = strm ? S0[(kb * 32 + crow(e, hi)) * 128 + db * 32 + n31] : 0.f; } }
    u32x4 rW[2], rQ[2], rK[2], rU[2], rA;
#define SC_LOAD(c) do { const int _row0 = (seg0 + (c)) * 64; _Pragma("unroll") for (int k = 0; k < 2; ++k) { const int id = tid + 512 * k, rr = id >> 4, c16 = id & 15; \
        rW[k] = *(const u32x4*)(Wb + (size_t)(_row0 + rr) * D + h * 128 + c16 * 8); const bf16_t* q = PRE + (size_t)(_row0 + rr) * DNQ + h * 128 + c16 * 8; \
        rQ[k] = *(const u32x4*)q; rU[k] = *(const u32x4*)(q + 2048); \
        rK[k] = *(const u32x4*)(PRE + (size_t)(_row0 + (id & 63)) * DNQ + 1024 + h * 128 + (id >> 6) * 8); }   \
        rA = *(const u32x4*)(ATT + (size_t)((seg0 + (c)) * 8 + h) * 4096 + (tid >> 3) * 64 + (tid & 7) * 8); } while (0)
#define SC_STORE() do { _Pragma("unroll") for (int k = 0; k < 2; ++k) { const int id = tid + 512 * k, rr = id >> 4, c16 = id & 15; \
        *(LAS u32x4*)(L + SC_W + rr * 272 + c16 * 16) = rW[k]; *(LAS u32x4*)(L + SC_QG + rr * 272 + c16 * 16) = rQ[k]; *(LAS u32x4*)(L + SC_U + rr * 272 + c16 * 16) = rU[k]; \
        LAS bf16_t* kt = (LAS bf16_t*)(L + SC_KGT) + ((id >> 6) * 8) * 72 + (id & 63); \
        kt[0] = (bf16_t)(rK[k].x & 0xffff); kt[72] = (bf16_t)(rK[k].x >> 16); kt[144] = (bf16_t)(rK[k].y & 0xffff); kt[216] = (bf16_t)(rK[k].y >> 16); \
        kt[288] = (bf16_t)(rK[k].z & 0xffff); kt[360] = (bf16_t)(rK[k].z >> 16); kt[432] = (bf16_t)(rK[k].w & 0xffff); kt[504] = (bf16_t)(rK[k].w >> 16); } \
        *(LAS u32x4*)(L + SC_AT + (tid >> 3) * 144 + (tid & 7) * 16) = rA; } while (0)
#define SC_WRITE_ST() do { _Pragma("unroll") for (int k2 = 0; k2 < 2; ++k2) { const int kb = ib * 2 + k2; _Pragma("unroll") for (int g = 0; g < 4; ++g) { u32x2 w2; w2.x = pk2(sacc[k2][4 * g], sacc[k2][4 * g + 1]); w2.y = pk2(sacc[k2][4 * g + 2], sacc[k2][4 * g + 3]); \
        *(LAS u32x2*)(L + SC_ST + (db * 32 + n31) * 272 + (kb * 32 + 8 * g + 4 * hi) * 2) = w2; } } } while (0)
    SC_LOAD(0); SC_STORE(); SC_WRITE_ST();
    float glast_n = GL[seg0 * 8 + h];
    lds_barrier();
    for (int c = 0; c < nsteps; ++c) {
        const int row0 = (seg0 + c) * 64; const float glast = glast_n;
        if (c + 1 < nsteps) { SC_LOAD(c + 1); glast_n = GL[(seg0 + c + 1) * 8 + h]; }
        f32x16 vacc, oacc;
#pragma unroll
        for (int e = 0; e < 16; ++e) { vacc[e] = bf2f(*(const LAS bf16_t*)(L + SC_U + (ib * 32 + crow(e, hi)) * 272 + (db * 32 + n31) * 2)); oacc[e] = 0.f; }
#pragma unroll 2
        for (int ks = 0; ks < 8; ++ks) {
            const bf16x8 bs = *(const LAS bf16x8*)(L + SC_ST + (db * 32 + n31) * 272 + ks * 32 + hi * 16);
            const bf16x8 aw = *(const LAS bf16x8*)(L + SC_W + (ib * 32 + n31) * 272 + ks * 32 + hi * 16);
            const bf16x8 aq = *(const LAS bf16x8*)(L + SC_QG + (ib * 32 + n31) * 272 + ks * 32 + hi * 16);
            vacc = MFMA32(aw, bs, vacc); oacc = MFMA32(aq, bs, oacc);
        }
#pragma unroll
        for (int g = 0; g < 4; ++g) { u32x2 w2; w2.x = pk2(vacc[4 * g], vacc[4 * g + 1]); w2.y = pk2(vacc[4 * g + 2], vacc[4 * g + 3]);
            *(LAS u32x2*)(L + SC_VNT + (db * 32 + n31) * 144 + (ib * 32 + 8 * g + 4 * hi) * 2) = w2; }
        lds_barrier();
#pragma unroll
        for (int ks = 0; ks < 4; ++ks) {
            const bf16x8 bv = *(const LAS bf16x8*)(L + SC_VNT + (db * 32 + n31) * 144 + ks * 32 + hi * 16);
            const bf16x8 aa = *(const LAS bf16x8*)(L + SC_AT + (ib * 32 + n31) * 144 + ks * 32 + hi * 16);
            oacc = MFMA32(aa, bv, oacc);
        }
#pragma unroll
        for (int k2 = 0; k2 < 2; ++k2) { const int kb = ib * 2 + k2;
#pragma unroll
            for (int e = 0; e < 16; ++e) sacc[k2][e] *= glast;
#pragma unroll
            for (int ks = 0; ks < 4; ++ks) {
                const bf16x8 bv = *(const LAS bf16x8*)(L + SC_VNT + (db * 32 + n31) * 144 + ks * 32 + hi * 16);
                const bf16x8 ak = *(const LAS bf16x8*)(L + SC_KGT + (kb * 32 + n31) * 144 + ks * 32 + hi * 16);
                sacc[k2] = MFMA32(ak, bv, sacc[k2]);
            } }
        lds_barrier();
        SC_WRITE_ST();
        if (c + 1 < nsteps) SC_STORE();
#pragma unroll
        for (int e = 0; e < 16; ++e) XNo[(size_t)(row0 + ib * 32 + crow(e, hi)) * D + h * 128 + db * 32 + n31] = f2bf(oacc[e]);
        lds_barrier();
    }
    { float* So = p.out + (strm ? O_DNS : O_DNP) + (size_t)(b * 8 + h) * 16384;
#pragma unroll
      for (int k2 = 0; k2 < 2; ++k2) { const int kb = ib * 2 + k2;
#pragma unroll
          for (int e = 0; e < 16; ++e) So[(kb * 32 + crow(e, hi)) * 128 + db * 32 + n31] = sacc[k2][e]; } }
#undef SC_LOAD
#undef SC_STORE
#undef SC_WRITE_ST
}

DI void dn_outnorm(const Params& p, int gw, int NGW, int lane) {
    const bf16_t* Z = (const bf16_t*)(p.out + O_KP); bf16_t* XN = (bf16_t*)(p.ws + WS_XN);
    const float* nw = p.in[17] + (lane & 7) * 16; const V8 n0 = v8_ldf(nw), n1 = v8_ldf(nw + 8);
    for (int row = gw; row < MA; row += NGW) {
        const bf16_t* o = XN + (size_t)row * D + lane * 16; const V8 o0 = v8_ldbf(o), o1 = v8_ldbf(o + 8);
        const bf16_t* z = Z + (size_t)row * D + lane * 16; const V8 z0 = v8_ldbf(z), z1 = v8_ldbf(z + 8);
        float ss = 0.f;
#pragma unroll
        for (int e = 0; e < 4; ++e) ss += o0.a[e] * o0.a[e] + o0.b[e] * o0.b[e] + o1.a[e] * o1.a[e] + o1.b[e] * o1.b[e];
        ss += __shfl_xor(ss, 1); ss += __shfl_xor(ss, 2); ss += __shfl_xor(ss, 4);
        const float rstd = rsqrtf(ss * (1.f / 128.f) + EPS);
        V8 r0, r1;
#pragma unroll
        for (int e = 0; e < 4; ++e) { r0.a[e] = o0.a[e] * rstd * n0.a[e] * silu_f(z0.a[e]); r0.b[e] = o0.b[e] * rstd * n0.b[e] * silu_f(z0.b[e]);
            r1.a[e] = o1.a[e] * rstd * n1.a[e] * silu_f(z1.a[e]); r1.b[e] = o1.b[e] * rstd * n1.b[e] * silu_f(z1.b[e]); }
        bf16_t* d = XN + (size_t)row * D + lane * 16; *(u32x4*)d = v8_pack(r0); *(u32x4*)(d + 8) = v8_pack(r1);
    }
}

DI void sb_attention(const Params& p, int gw, int NGW, int lane) {
    const bf16_t* Q = (const bf16_t*)(p.ws + WS_Q); bf16_t* O = (bf16_t*)(p.ws + WS_XN);
    const int n31 = lane & 31, hi = lane >> 5;
    for (int item = gw; item < 16384 + 256; item += NGW) {
        int b, h, q0, kb_start, Lrow; size_t qrow0; const bf16_t* Kb; const bf16_t* VT;
        if (item < 16384) { b = item >> 11; h = (item >> 7) & 15; const int strip = item & 127; q0 = strip * 32; qrow0 = (size_t)b * 4096 + q0; kb_start = strip; Lrow = 4096;
            Kb = (const bf16_t*)(p.ws + WS_KP) + (size_t)b * 4096 * D + h * 64; VT = (const bf16_t*)(p.ws + WS_VTP) + (size_t)(b * 16 + h) * 64 * 4096; }
        else { const int it = item - 16384; b = it >> 5; h = (it >> 1) & 15; const int strip = it & 1; q0 = strip * 32; qrow0 = (size_t)MP + b * 64 + q0; kb_start = 64 + strip; Lrow = LK;
            Kb = (const bf16_t*)(p.ws + WS_KS) + (size_t)b * LK * D + h * 64; VT = (const bf16_t*)(p.ws + WS_VTS) + (size_t)(b * 16 + h) * 64 * LK; }
        bf16x8 qf[4];
#pragma unroll
        for (int d0 = 0; d0 < 4; ++d0) qf[d0] = *(const bf16x8*)(Q + (qrow0 + n31) * D + h * 64 + d0 * 16 + hi * 8);
        f32x16 oacc[2];
#pragma unroll
        for (int e = 0; e < 16; ++e) { oacc[0][e] = 0.f; oacc[1][e] = 0.f; }
        float R = 0.f;
        for (int kb = kb_start; kb >= 0; --kb) {
            const int key0 = kb * 32; const bool diag = (kb == kb_start);
            f32x16 c;
#pragma unroll
            for (int e = 0; e < 16; ++e) c[e] = 0.f;
#pragma unroll
            for (int d0 = 0; d0 < 4; ++d0) { const bf16x8 kf = *(const bf16x8*)(Kb + (size_t)(key0 + n31) * D + d0 * 16 + hi * 8); c = MFMA32(kf, qf[d0], c); }
            u32x2 vlo[2][2], vhi[2][2];
#pragma unroll
            for (int s2 = 0; s2 < 2; ++s2)
#pragma unroll
                for (int dblk = 0; dblk < 2; ++dblk) { const bf16_t* vp = VT + (size_t)(dblk * 32 + n31) * Lrow + key0 + 16 * s2 + 4 * hi; vlo[s2][dblk] = *(const u32x2*)vp; vhi[s2][dblk] = *(const u32x2*)(vp + 8); }
            float sp[16], ls[16];
#pragma unroll
            for (int e = 0; e < 16; ++e) {
                const float z = c[e] * 0.125f; const float az = fabsf(z);
                const float l = __builtin_amdgcn_logf(1.f + __builtin_amdgcn_exp2f(-az * 1.4426950408889634f)) * 0.6931471805599453f;
                const bool valid = !diag || (crow(e, hi) < n31);
                sp[e] = valid ? fmaxf(z, 0.f) + l : 0.f; ls[e] = valid ? fminf(z, 0.f) - l : -1e30f;
            }
            float Town[4], Toth[4];
#pragma unroll
            for (int g = 0; g < 4; ++g) { Town[g] = (sp[4 * g] + sp[4 * g + 1]) + (sp[4 * g + 2] + sp[4 * g + 3]); Toth[g] = __shfl_xor(Town[g], 32); }
            float suf = R;
            float pa[16];
#pragma unroll
            for (int g = 3; g >= 0; --g) {
                const float base = suf + (hi == 0 ? Toth[g] : 0.f);
                const float r3 = base, r2 = r3 + sp[4 * g + 3], r1 = r2 + sp[4 * g + 2], r0 = r1 + sp[4 * g + 1];
                pa[4 * g + 3] = __builtin_amdgcn_exp2f((ls[4 * g + 3] - r3) * 1.4426950408889634f);
                pa[4 * g + 2] = __builtin_amdgcn_exp2f((ls[4 * g + 2] - r2) * 1.4426950408889634f);
                pa[4 * g + 1] = __builtin_amdgcn_exp2f((ls[4 * g + 1] - r1) * 1.4426950408889634f);
                pa[4 * g + 0] = __builtin_amdgcn_exp2f((ls[4 * g + 0] - r0) * 1.4426950408889634f);
                suf += Town[g] + Toth[g];
            }
            R = suf;
#pragma unroll
            for (int s2 = 0; s2 < 2; ++s2) {
                u32x4 pw; pw.x = pk2(pa[8 * s2], pa[8 * s2 + 1]); pw.y = pk2(pa[8 * s2 + 2], pa[8 * s2 + 3]); pw.z = pk2(pa[8 * s2 + 4], pa[8 * s2 + 5]); pw.w = pk2(pa[8 * s2 + 6], pa[8 * s2 + 7]);
                const bf16x8 pb = __builtin_bit_cast(bf16x8, pw);
#pragma unroll
                for (int dblk = 0; dblk < 2; ++dblk) { u32x4 vw; vw.x = vlo[s2][dblk].x; vw.y = vlo[s2][dblk].y; vw.z = vhi[s2][dblk].x; vw.w = vhi[s2][dblk].y;
                    oacc[dblk] = MFMA32(__builtin_bit_cast(bf16x8, vw), pb, oacc[dblk]); }
            }
            if (__all(R > 104.f)) break;
        }
#pragma unroll
        for (int dblk = 0; dblk < 2; ++dblk)
#pragma unroll
            for (int g = 0; g < 4; ++g) { u32x2 w2; w2.x = pk2(oacc[dblk][4 * g], oacc[dblk][4 * g + 1]); w2.y = pk2(oacc[dblk][4 * g + 2], oacc[dblk][4 * g + 3]);
                *(u32x2*)(O + (qrow0 + n31) * D + h * 64 + dblk * 32 + 8 * g + 4 * hi) = w2; }
    }
}

#define XB_TMO      128
#define XB_XCNT(j)  (256  + 64 * (j))
#define XB_XSUB(j)  (1280 + 64 * (j))
#define XB_XGEN(j)  (2304 + 64 * (j))
#define XB_TOP      3328
#define XB_TOPGEN   3392
#define XCD_BAR_WORDS 3456
#define XB_SPIN_CAP (1u << 18)

__device__ __forceinline__ unsigned xb_ld(unsigned* p)              { return __hip_atomic_load(p, __ATOMIC_RELAXED, __HIP_MEMORY_SCOPE_AGENT); }
__device__ __forceinline__ unsigned xb_add(unsigned* p, unsigned v) { return __hip_atomic_fetch_add(p, v, __ATOMIC_RELAXED, __HIP_MEMORY_SCOPE_AGENT); }
__device__ __forceinline__ unsigned xb_xcc_id() { return (unsigned)__builtin_amdgcn_s_getreg((3 << 11) | 20) & 0xFu; }
#define XB_SPIN(cond, bar) do { unsigned _sp = 0; while (cond) { __builtin_amdgcn_s_sleep(1); \
    if ((++_sp & 255u) == 0u) { if (xb_ld(&(bar)[XB_TMO])) break; if (_sp > XB_SPIN_CAP) { atomicAdd(&(bar)[XB_TMO], 1u); break; } } } } while (0)

struct XcdBarrier {
    unsigned* bar; unsigned x;
    volatile LAS unsigned* st;
};

__device__ __forceinline__ XcdBarrier xcd_barrier_post(unsigned* bar, volatile LAS unsigned* st) {
    XcdBarrier b; b.bar = bar; b.x = xb_xcc_id(); b.st = st;
    if (threadIdx.x == 0) (void)xb_add(&bar[XB_XCNT(b.x)], 1u);
    return b;
}
__device__ __forceinline__ void xcd_barrier_complete(unsigned* bar, unsigned x, unsigned& nloc, unsigned& nx) {
    const unsigned G = gridDim.x * gridDim.y * gridDim.z;
    unsigned sum, cnt, mine, sp = 0u;
    for (;;) {
        sum = 0u; cnt = 0u; mine = 0u;
#pragma unroll
        for (unsigned j = 0; j < 16; ++j) { const unsigned c = xb_ld(&bar[XB_XCNT(j)]); sum += c; cnt += (c > 0u) ? 1u : 0u; mine = (j == x) ? c : mine; }
        if (sum == G) break;
        __builtin_amdgcn_s_sleep(1);
        if ((++sp & 255u) == 0u) { if (xb_ld(&bar[XB_TMO])) break; if (sp > XB_SPIN_CAP) { atomicAdd(&bar[XB_TMO], 1u); break; } }
    }
    nloc = mine > 0u ? mine : 1u; nx = cnt > 0u ? cnt : 1u;
}

__device__ __forceinline__ void xcd_barrier(const XcdBarrier& b) {
    asm volatile("s_waitcnt vmcnt(0)" ::: "memory");
    __syncthreads();
    if (threadIdx.x == 0) {
        unsigned* bar = b.bar;
        __builtin_amdgcn_s_waitcnt(0);
        unsigned nloc = b.st[0], nx = b.st[1];
        if (nloc == 0u) { xcd_barrier_complete(bar, b.x, nloc, nx); b.st[0] = nloc; b.st[1] = nx; }
        const unsigned old = xb_add(&bar[XB_XSUB(b.x)], 1u);
        const unsigned gen = old / nloc;
        if (old + 1u == (gen + 1u) * nloc) {
            __builtin_amdgcn_fence(__ATOMIC_RELEASE, "agent");
            asm volatile("s_waitcnt vmcnt(0)" ::: "memory");
            const unsigned og = xb_add(&bar[XB_TOP], 1u);
            const unsigned tg = og / nx;
            if (og + 1u == (tg + 1u) * nx) xb_add(&bar[XB_TOPGEN], 1u);
            else XB_SPIN(xb_ld(&bar[XB_TOPGEN]) == tg, bar);
            __builtin_amdgcn_fence(__ATOMIC_ACQUIRE, "agent");
            xb_add(&bar[XB_XGEN(b.x)], 1u);
            asm volatile("s_waitcnt vmcnt(0)" ::: "memory");
        } else {
            XB_SPIN(xb_ld(&bar[XB_XGEN(b.x)]) == gen, bar);
            __builtin_amdgcn_fence(__ATOMIC_ACQUIRE, "agent");
            asm volatile("s_waitcnt vmcnt(0)" ::: "memory");
        }
    }
    __syncthreads();
}


enum { T_A = 0, T_PD, T_GMIX, T_GDNIN, T_DN2, T_DN3, T_DN4, T_GQKV, T_ATT, T_NF, T_GUP, T_GDOWN, T_FINAL };
constexpr int N_PHASES = 29;
DI void decode_phase(int ph, int& type, int& layer) {
    int k;
    if (ph < 6) { layer = 0; k = ph; } else if (ph < 15) { layer = 1; k = ph - 6; } else if (ph < 22) { layer = 2; k = ph - 15; } else if (ph < 28) { layer = 3; k = ph - 22; } else { layer = 4; type = T_FINAL; return; }
    if (k == 0) { type = T_A; return; }
    const int nm = (layer == 1) ? 6 : (layer == 2 ? 4 : 3);
    if (k >= nm) { type = T_NF + (k - nm); return; }
    if (layer == 1) { type = (k == 1) ? T_GDNIN : (k == 2) ? T_DN2 : (k == 3) ? T_DN3 : (k == 4) ? T_DN4 : T_GMIX; }
    else if (layer == 2) { type = (k == 1) ? T_GQKV : (k == 2) ? T_ATT : T_GMIX; }
    else { type = (k == 1) ? T_PD : T_GMIX; }
}

__global__ void __launch_bounds__(512, 2) mega_fwd(Params p0) {
    extern __shared__ __attribute__((aligned(16))) unsigned char lds_raw[];
    LAS unsigned char* L = (LAS unsigned char*)lds_raw;
    const int tid0 = threadIdx.x, wave0 = __builtin_amdgcn_readfirstlane(tid0 >> 6);
    const int G = gridDim.x, NGW = G * 8, NT = G * 512;
    volatile LAS unsigned* xb_st = (volatile LAS unsigned*)(L + LDS_BYTES - 64);
    if (tid0 < 2) xb_st[tid0] = 0u;
    __syncthreads();
    XcdBarrier bar = xcd_barrier_post((unsigned*)(p0.ws + WS_CTL), xb_st);
    if (p0.lo < 0) cg::this_grid().sync();
    for (int ph = p0.lo; ph < p0.hi; ++ph) {
        int type, layer; decode_phase(ph, type, layer);
#define P_LAUNDER int tid = tid0, wave = wave0, bid = blockIdx.x; asm volatile("" : "+v"(tid), "+s"(wave), "+s"(bid)); const int lane = tid & 63, gw = bid * 8 + wave, gtid = bid * 512 + tid; (void)lane; (void)gw; (void)gtid; Params p = p0; { unsigned char* w_ = p0.ws; float* o_ = p0.out; asm volatile("" : "+s"(w_), "+s"(o_)); p.ws = w_; p.out = o_; } bf16_t* XN = (bf16_t*)(p.ws + WS_XN); (void)XN
#ifndef PH_MASK
#define PH_MASK 0xffffffffu
#endif
#define EN(t) ((PH_MASK >> (t)) & 1u)
#ifndef REPMASK
#define REPMASK 0u
#endif
        const int reps = ((REPMASK >> type) & 1u) ? 2 : 1;
        for (int rp = 0; rp < reps; ++rp) {
        switch (type) {
        case T_A: if (EN(T_A)) { P_LAUNDER;
            LAS float* scr = (LAS float*)(L + wave * 16640);
            if (layer == 0 || (layer == 1 && G <= 44)) convert_layer_weights(p, layer, scr, gw, NGW, lane);
            if (layer == 2 && G <= 128) sb_cache_convert(p, scr, gtid, NT, gw, NGW, lane);
            norm_rows<false>(p, p.in[8] + (size_t)layer * D, layer == 0 ? 1 : 0, layer == 0 ? 0 : FF / 128, (layer == 0 || layer == 3) ? layer / 3 : -1, gw, NGW, lane);
        } break;
        case T_PD: if (EN(T_PD)) { P_LAUNDER; pool_diff(p, layer / 3, gtid, NT); } break;
        case T_GMIX: case T_GDOWN: if (EN(T_GMIX)) { P_LAUNDER;
            pg8::Gemm g; EpiRes E; E.base0 = p.out; E.base1 = nullptr; E.out = p.out; E.scale = nullptr;
            if (type == T_GDOWN) { g = pg8::Gemm{(const bf16_t*)(p.ws + WS_V), (const bf16_t*)(p.ws + w_dn(layer)), MA, D, FF, FF, FF, 0}; }
            else if (layer == 0 || layer == 3) { g = pg8::Gemm{(const bf16_t*)(p.ws + WS_BIG), (const bf16_t*)(p.ws + w_mix(layer)), MA, D, 256, D, 256, 256}; E.scale = p.in[12] + (size_t)(layer / 3) * D;
                if (layer == 0) { E.base0 = p.in[0]; E.base1 = p.in[1]; } }
            else { g = pg8::Gemm{XN, (const bf16_t*)(p.ws + w_mix2(layer)), MA, D, D, D, D, 0}; }
            E.part = (float*)(p.ws + WS_PART); E.dry = (rp + 1 < reps);
            pg8::ResOrder S; S.init(g.K, G, bid); pg8::gemm_phase<EpiRes, pg8::ResOrder>(L, g, S, E, tid);
        } break;
        case T_GDNIN: if (EN(T_GDNIN)) { P_LAUNDER;
            pg8::Gemm g{XN, (const bf16_t*)(p.ws + w_mix(1)), MA, DNINP, D, D, D, 0}; pg8::StaticOrder S; S.init(MA, DNINP, D, G, bid);
            EpiDnIn E{(bf16_t*)(p.ws + WS_PRE), (bf16_t*)(p.out + O_KP), (float*)(p.ws + WS_AB), (bf16_t*)(p.ws + WS_HALO), p.out};
            pg8::gemm_phase<EpiDnIn, pg8::StaticOrder>(L, g, S, E, tid);
        } break;
        case T_DN2: if (EN(T_DN2)) { P_LAUNDER; dn_intra(p, L, tid, wave, bid, G, rp + 1 < reps); } break;
        case T_DN3: if (EN(T_DN3)) { P_LAUNDER; dn_scan(p, L, tid, wave, lane, bid, G); } break;
        case T_DN4: if (EN(T_DN4)) { P_LAUNDER; dn_outnorm(p, gw, NGW, lane); } break;
        case T_GQKV: if (EN(T_GQKV)) { P_LAUNDER;
            pg8::Gemm g{XN, (const bf16_t*)(p.ws + w_mix(2)), MA, 3 * D, D, D, D, 0}; pg8::StaticOrder S; S.init(MA, 3 * D, D, G, bid);
            EpiQkv E{(bf16_t*)(p.ws + WS_Q), (bf16_t*)(p.ws + WS_KP), (bf16_t*)(p.ws + WS_VTP), (bf16_t*)(p.ws + WS_KS), (bf16_t*)(p.ws + WS_VTS), p.out, L + 131072};
            pg8::gemm_phase<EpiQkv, pg8::StaticOrder>(L, g, S, E, tid);
        } break;
        case T_ATT: if (EN(T_ATT)) { P_LAUNDER; sb_attention(p, gw, NGW, lane); } break;
        case T_NF: if (EN(T_NF)) { P_LAUNDER; norm_rows<false>(p, p.in[9] + (size_t)layer * D, layer == 0 ? 2 : 0, (layer == 0 || layer == 3) ? 2 : 8, -1, gw, NGW, lane); } break;
        case T_GUP: if (EN(T_GUP)) { P_LAUNDER;
            EpiUp E{(bf16_t*)(p.ws + WS_V), (float*)(p.ws + WS_SG0), (float*)(p.ws + WS_SV0), (float*)(p.ws + WS_SGL), p.out, p.in[22] + (size_t)layer * 3 * FF, p.in[23] + (size_t)layer * FF, layer, p.in[7] + (size_t)layer * 8 * 2 * FF};
            { pg8::Gemm g{XN, (const bf16_t*)(p.ws + w_up(layer)), MP, NUP, D, D, D, 0}; pg8::StaticOrder S; S.init(MP, NUP, D, G, bid);
              pg8::gemm_phase<EpiUp, pg8::StaticOrder>(L, g, S, E, tid); }
            xcd_barrier(bar);
            if (bid < 44 || G <= 44) { pg8::Gemm g{XN, (const bf16_t*)(p.ws + w_up(layer)), MA, NUP, D, D, D, 0}; pg8::SampleUpOrder S; S.c = bid;
                for (int c2 = bid; c2 < 44; c2 += G) { S.c = c2; pg8::gemm_phase<EpiUp, pg8::SampleUpOrder>(L, g, S, E, tid); } }
            if (bid >= 44 || G <= 44) { const int nb = (G > 44) ? G - 44 : G, b0 = (G > 44) ? bid - 44 : bid;
                ffn_hidden(p, layer, b0 * 512 + tid, nb * 512);
                if (layer == 0) { LAS float* scr = (LAS float*)(L + wave * 16640); convert_layer_weights(p, 1, scr, b0 * 8 + wave, nb * 8, lane); } }
        } break;
        default: if (EN(T_FINAL)) { P_LAUNDER; norm_rows<true>(p, p.in[10], 0, FF / 128, -1, gw, NGW, lane); } break;
        }
        if (rp + 1 < reps) xcd_barrier(bar);
        }
        if (ph + 1 < p0.hi) xcd_barrier(bar);
#ifdef EXTRA_SYNCS
        if (ph == 0) { for (int q = 0; q < EXTRA_SYNCS; ++q) xcd_barrier(bar); }
#endif
    }
}

extern "C" void kernel_launch(void* const* d_in, const int* in_sizes, int n_in, void* d_out, int out_size, void* d_ws, size_t ws_size, hipStream_t stream) {
    static int grid = 0;
    if (grid == 0) {
        if (n_in != 25 || (size_t)out_size != O_END || ws_size < WS_END) { fprintf(stderr, "kernel_launch: unexpected shapes: n_in %d out %d ws %zu\n", n_in, out_size, ws_size); grid = -1; return; }
        int dev = 0, cus = 0, per_cu = 0;
        hipGetDevice(&dev); hipDeviceGetAttribute(&cus, hipDeviceAttributeMultiprocessorCount, dev);
        if (hipFuncSetAttribute((const void*)mega_fwd, hipFuncAttributeMaxDynamicSharedMemorySize, LDS_BYTES) != hipSuccess) { fprintf(stderr, "kernel_launch: hipFuncSetAttribute failed\n"); grid = -1; return; }
        if (hipOccupancyMaxActiveBlocksPerMultiprocessor(&per_cu, (const void*)mega_fwd, 512, LDS_BYTES) != hipSuccess || per_cu < 1) { fprintf(stderr, "kernel_launch: occupancy query says %d\n", per_cu); per_cu = 1; }
        (void)hipGetLastError();
        grid = cus * 1;
    }
    if (grid < 0) return;
    if (hipMemsetAsync((char*)d_ws + WS_CTL, 0, CTL_BYTES, stream) != hipSuccess) { fprintf(stderr, "kernel_launch: memset failed\n"); return; }
    Params p{};
    for (int i = 0; i < 25; ++i) p.in[i] = (const float*)d_in[i];
    p.out = (float*)d_out; p.ws = (unsigned char*)d_ws;
#if MK_ONE_LAUNCH
    p.lo = 0; p.hi = N_PHASES;
    void* args[] = {&p};
    hipError_t e = hipLaunchCooperativeKernel((const void*)mega_fwd, dim3(grid), dim3(512), args, LDS_BYTES, stream);
    if (e != hipSuccess) fprintf(stderr, "cooperative launch failed: %s (grid %d)\n", hipGetErrorString(e), grid);
#else
    for (int ph = 0; ph < N_PHASES; ++ph) { p.lo = ph; p.hi = ph + 1; hipLaunchKernelGGL(mega_fwd, dim3(grid), dim3(512), LDS_BYTES, stream, p); }
#endif
}
```

```cpp
#include <hip/hip_runtime.h>
#include <hip/hip_cooperative_groups.h>
#include <cstdio>
#include <cstdint>
namespace cg = cooperative_groups;

#ifndef MK_ONE_LAUNCH
#define MK_ONE_LAUNCH 1
#endif

#define LAS __attribute__((address_space(3)))
typedef unsigned short bf16_t;
typedef short bf16x8 __attribute__((ext_vector_type(8)));
typedef float f32x2 __attribute__((ext_vector_type(2)));
typedef float f32x4 __attribute__((ext_vector_type(4)));
typedef float f32x16 __attribute__((ext_vector_type(16)));
typedef unsigned u32x2 __attribute__((ext_vector_type(2)));
typedef unsigned u32x4 __attribute__((ext_vector_type(4)));
typedef __bf16 bf16x2_t __attribute__((ext_vector_type(2)));
#define DI __device__ __forceinline__

constexpr int D = 1024, MP = 32768, MS = 512, MA = MP + MS, PAST = 2048, LK = PAST + 64;
constexpr int FF = 2816, NUP = 5632, DNQ = 3072, DNIN = 4112, DNINP = 4352;
constexpr int NSEG = MA / 64;
constexpr float EPS = 1e-6f;
constexpr size_t O_POOLP = (size_t)MA * D;
constexpr size_t O_POOLS = O_POOLP + 2 * 8 * 15 * D;
constexpr size_t O_DNCP = O_POOLS + 2 * 8 * 15 * D;
constexpr size_t O_DNCS = O_DNCP + 8 * 3 * DNQ;
constexpr size_t O_DNP = O_DNCS + 8 * 3 * DNQ;
constexpr size_t O_DNS = O_DNP + 8 * 8 * 128 * 128;
constexpr size_t O_KP = O_DNS + 8 * 8 * 128 * 128;
constexpr size_t O_KS = O_KP + (size_t)MP * D;
constexpr size_t O_VP = O_KS + (size_t)MS * D;
constexpr size_t O_VS = O_VP + (size_t)MP * D;
constexpr size_t O_FFNP = O_VS + (size_t)MS * D;
constexpr size_t O_FFNS = O_FFNP + 4 * 8 * 2 * FF;
constexpr size_t O_END = O_FFNS + 4 * 8 * 2 * FF;
constexpr size_t MiB = 1u << 20;
constexpr size_t WS_WUP = 0, WS_WDN = 11 * MiB, WS_WMIX = 17 * MiB, WS_WMIX2 = 26 * MiB, WS_AB = 28 * MiB, WS_GL = 31 * MiB, WS_HALO = 31 * MiB + 256 * 1024;
constexpr size_t WS_XN = 41 * MiB, WS_BIG = 106 * MiB;
constexpr size_t WS_V = WS_BIG, WS_SG0 = WS_BIG + 179 * MiB, WS_SV0 = WS_BIG + 191 * MiB, WS_SGL = WS_BIG + 203 * MiB, WS_PART = WS_BIG + 215 * MiB;
constexpr size_t WS_PRE = WS_BIG, WS_W = WS_BIG + 195 * MiB;
constexpr size_t WS_Q = WS_BIG, WS_KP = WS_Q + 65 * MiB, WS_VTP = WS_KP + 64 * MiB, WS_KS = WS_BIG + 260 * MiB, WS_VTS = WS_KS + 33 * MiB;
constexpr size_t WS_W2UP = 464 * MiB, WS_W2DN = 475 * MiB, WS_W2MIX = 481 * MiB, WS_W2MIX2 = 487 * MiB, WS_W3UP = 489 * MiB, WS_W3DN = 500 * MiB, WS_W3MIX = 506 * MiB;
constexpr size_t WS_CTL = 507 * MiB, CTL_BYTES = 65536;
constexpr size_t WS_END = 508 * MiB;
constexpr size_t WS_W1UP = WS_BIG + 326 * MiB, WS_W1DN = WS_BIG + 337 * MiB, WS_W1MIX = WS_BIG + 343 * MiB, WS_W1MIX2 = WS_BIG + 352 * MiB;
DI size_t w_up(int l) { return l == 0 ? WS_WUP : (l == 1 ? WS_W1UP : (l == 2 ? WS_W2UP : WS_W3UP)); }
DI size_t w_dn(int l) { return l == 0 ? WS_WDN : (l == 1 ? WS_W1DN : (l == 2 ? WS_W2DN : WS_W3DN)); }
DI size_t w_mix(int l) { return l == 0 ? WS_WMIX : (l == 1 ? WS_W1MIX : (l == 2 ? WS_W2MIX : WS_W3MIX)); }
DI size_t w_mix2(int l) { return l == 1 ? WS_W1MIX2 : WS_W2MIX2; }
constexpr int LDS_BYTES = 147456;

struct Params { const float* in[25]; float* out; unsigned char* ws; int lo, hi; };

DI unsigned pk2(float lo, float hi) { f32x2 v = {lo, hi}; bf16x2_t b = __builtin_convertvector(v, bf16x2_t); return __builtin_bit_cast(unsigned, b); }
DI float bflo(unsigned u) { return __uint_as_float(u << 16); }
DI float bfhi(unsigned u) { return __uint_as_float(u & 0xffff0000u); }
DI bf16_t f2bf(float f) { return (bf16_t)(pk2(f, 0.f) & 0xffffu); }
DI float bf2f(bf16_t b) { return __uint_as_float(((unsigned)b) << 16); }
DI int crow(int r, int hi) { return (r & 3) + 8 * (r >> 2) + 4 * hi; }
DI void rowinfo(int row, int& s, int& b, int& t) { if (row < MP) { s = 0; b = row >> 12; t = row & 4095; } else { const int r = row - MP; s = 1; b = r >> 6; t = r & 63; } }
DI float wave_sum(float v) {
#pragma unroll
    for (int o = 1; o < 64; o <<= 1) v += __shfl_xor(v, o);
    return v;
}
struct V8 { f32x4 a, b; };
DI V8 v8zero() { V8 r; r.a = (f32x4){0.f, 0.f, 0.f, 0.f}; r.b = r.a; return r; }
DI V8 v8_from_bf(u32x4 w) { V8 r; r.a = (f32x4){bflo(w.x), bfhi(w.x), bflo(w.y), bfhi(w.y)}; r.b = (f32x4){bflo(w.z), bfhi(w.z), bflo(w.w), bfhi(w.w)}; return r; }
DI V8 v8_ldf(const float* p) { V8 r; r.a = *(const f32x4*)p; r.b = *(const f32x4*)(p + 4); return r; }
DI V8 v8_ldbf(const bf16_t* p) { return v8_from_bf(*(const u32x4*)p); }
DI u32x4 v8_pack(const V8& v) { u32x4 w; w.x = pk2(v.a.x, v.a.y); w.y = pk2(v.a.z, v.a.w); w.z = pk2(v.b.x, v.b.y); w.w = pk2(v.b.z, v.b.w); return w; }
#define MFMA32(a, b, c) __builtin_amdgcn_mfma_f32_32x32x16_bf16((a), (b), (c), 0, 0, 0)

namespace pg8 {
constexpr int BM = 256, BK = 64, HALF = 128, HTB = HALF * BK * 2, STAGE_BYTES = 8 * HTB, NXCD = 8, WGM = 8;
DI int lds_byte(int r, int c) { const int st = (r >> 4) * 2 + (c >> 5), rr = r & 15, cc = c & 31, ob = rr * 64 + cc * 2; return st * 1024 + (ob ^ (((ob >> 9) & 1) << 5)); }
DI void stage_rc(int b, int& R, int& C) { const int st = b / 1024, sb = b % 1024, swz = sb ^ (((sb >> 9) & 1) << 5); R = (st >> 1) * 16 + swz / 64; C = (st & 1) * 32 + (swz % 64) / 2; }
DI int perm32(int rho) { const int n = rho >> 4, i = rho & 15; return 8 * (i >> 2) + 4 * n + (i & 3); }
struct Unit { int pm, pn, k0, np; };
struct Gemm { const bf16_t* A; const bf16_t* Bt; int M, N, K, lda, ldb, acol; };
struct StaticOrder {
    int nM, nN, nwg, G, c, npu;
    DI void init(int M, int N, int K, int G_, int c_) { nM = M / BM; nN = N / BM; nwg = nM * nN; G = G_; c = c_; npu = K / 128; }
    DI bool next(int i, Unit& u) const {
        const long L = (long)i * G + c; if (L >= nwg) return false;
        int wgid = (int)L; { const int q = nwg / NXCD, r = nwg % NXCD, xcd = wgid % NXCD, off = wgid / NXCD; wgid = (xcd < r ? xcd * (q + 1) : r * (q + 1) + (xcd - r) * q) + off; }
        const int nig = WGM * nN, gid = wgid / nig, fm = gid * WGM, gsz = (nM - fm) < WGM ? (nM - fm) : WGM;
        u.pm = fm + ((wgid % nig) % gsz); u.pn = (wgid % nig) / gsz; u.k0 = 0; u.np = npu; return true;
    }
};
struct ResOrder {
    StaticOrder so; int npu, G, c;
    DI void init(int K, int G_, int c_) { so.init(MP, D, K, G_, c_); npu = K / 128; G = G_; c = c_; }
    DI bool next(int i, Unit& u) const {
        const int rp = (512 + G - 1) / G;
        if (i < rp) { if (so.next(i, u)) return true; }
        const int j = i < rp ? rp : i;
        if (i < rp) return false;
        const long mi = (long)(j - rp) * G + c; if (mi >= 8 * npu) return false;
        const int unit = (int)(mi / npu); u.pm = 128 + unit / 4; u.pn = unit % 4; u.k0 = (int)(mi % npu); u.np = 1; return true;
    }
};
struct SampleUpOrder {
    int c;
    DI bool next(int i, Unit& u) const { if (i > 0 || c >= 44) return false; u.pm = 128 + c / 22; u.pn = c % 22; u.k0 = 0; u.np = 8; return true; }
};
template <class Epi, class Sched>
DI void gemm_phase(LAS unsigned char* lds, const Gemm g, const Sched& S, const Epi& E, const int tid) {
    const int wid = __builtin_amdgcn_readfirstlane(tid >> 6), lane = tid & 63, wr = wid >> 2, wc = wid & 3, fr = lane & 15, fq = lane >> 4;
    unsigned voffA[2], voffB[2];
#pragma unroll
    for (int i = 0; i < 2; ++i) { int R, C; stage_rc(tid * 16 + i * 8192, R, C); const int Rb = Epi::PERM ? ((R & ~31) + perm32(R & 31)) : R;
        voffA[i] = (unsigned)(R * g.lda + C) * 2u; voffB[i] = (unsigned)(Rb * g.ldb + C) * 2u; }
    const size_t kstep = (size_t)(BK * 2);
    const size_t hstepA = (size_t)HALF * g.lda * 2, hstepB = (size_t)HALF * g.ldb * 2;
    const size_t tstepA = 2 * hstepA, tstepB = 2 * hstepB;
    const unsigned ldsw = (unsigned)wid * 1024u;
    const int aoff = lds_byte(wr * 64 + fr, fq * 8), boff = lds_byte(wc * 32 + fr, fq * 8);
#define PG8_SA(b, h) (((b) * 2 + (h)) * HTB)
#define PG8_SB(b, h) ((4 + (b) * 2 + (h)) * HTB)
#define PG8_STAGE(bufoff, gbase, voff) do { _Pragma("unroll") for (int _i = 0; _i < 2; ++_i) \
        __builtin_amdgcn_global_load_lds((const unsigned*)((const char*)(gbase) + (voff)[_i]), (LAS unsigned*)(lds + (bufoff) + ldsw + _i * 8192), 16, 0, 0); } while (0)
#define PG8_LDA(dst, b, h) do { _Pragma("unroll") for (int m = 0; m < 4; ++m) _Pragma("unroll") for (int k = 0; k < 2; ++k) dst[m][k] = *(const LAS bf16x8*)(lds + PG8_SA(b, h) + aoff + m * 2048 + k * 1024); } while (0)
#define PG8_LDB(dst, b, h) do { _Pragma("unroll") for (int n = 0; n < 2; ++n) _Pragma("unroll") for (int k = 0; k < 2; ++k) dst[n][k] = *(const LAS bf16x8*)(lds + PG8_SB(b, h) + boff + n * 2048 + k * 1024); } while (0)
#define PG8_MMA(ai, bj, At, Bt) do { __builtin_amdgcn_s_setprio(1); _Pragma("unroll") for (int m = 0; m < 4; ++m) _Pragma("unroll") for (int n = 0; n < 2; ++n) _Pragma("unroll") for (int k = 0; k < 2; ++k) \
        acc[ai][bj][m][n] = __builtin_amdgcn_mfma_f32_16x16x32_bf16(Bt[n][k], At[m][k], acc[ai][bj][m][n], 0, 0, 0); __builtin_amdgcn_s_setprio(0); } while (0)
#define PG8_WAIT_V(n) asm volatile("s_waitcnt vmcnt(" #n ")" ::: "memory")
#define PG8_WAIT_L(n) asm volatile("s_waitcnt lgkmcnt(" #n ")" ::: "memory")
#define PG8_BAR __builtin_amdgcn_s_barrier()
#define PG8_SCHED __builtin_amdgcn_sched_barrier(0)
    Unit cur, nxt; int ui = 0;
    if (!S.next(0, cur)) return;
    f32x4 acc[2][2][4][2];
#pragma unroll
    for (int a = 0; a < 2; ++a)
#pragma unroll
        for (int b = 0; b < 2; ++b)
#pragma unroll
            for (int m = 0; m < 4; ++m)
#pragma unroll
                for (int n = 0; n < 2; ++n) acc[a][b][m][n] = (f32x4){0.f, 0.f, 0.f, 0.f};
    bf16x8 At[4][2], B0[2][2], B1[2][2];
    const char* cA = (const char*)g.A + (size_t)cur.pm * tstepA + (size_t)cur.pn * g.acol * 2 + (size_t)cur.k0 * 256; const char* cB = (const char*)g.Bt + (size_t)cur.pn * tstepB + (size_t)cur.k0 * 256;
    PG8_STAGE(PG8_SB(0, 0), cB, voffB); PG8_STAGE(PG8_SB(0, 1), cB + hstepB, voffB); PG8_STAGE(PG8_SA(0, 0), cA, voffA); PG8_STAGE(PG8_SA(0, 1), cA + hstepA, voffA);
    if (wr == 1) PG8_BAR;
    PG8_WAIT_V(2); PG8_BAR;
    PG8_STAGE(PG8_SB(1, 0), cB + kstep, voffB); PG8_STAGE(PG8_SA(1, 0), cA + kstep, voffA); PG8_STAGE(PG8_SB(1, 1), cB + hstepB + kstep, voffB);
    PG8_WAIT_V(6); PG8_BAR;
    for (;;) {
        const bool has_next = S.next(ui + 1, nxt);
        const char* nA = has_next ? (const char*)g.A + (size_t)nxt.pm * tstepA + (size_t)nxt.pn * g.acol * 2 + (size_t)nxt.k0 * 256 : cA; const char* nB = has_next ? (const char*)g.Bt + (size_t)nxt.pn * tstepB + (size_t)nxt.k0 * 256 : cB;
        const int nt = 2 * cur.np;
        for (int t = 0; t < nt; t += 2) {
            const bool last = (t == nt - 2);
            const char* a1 = cA + (size_t)(t + 1) * kstep;
            const char* a2 = last ? nA : cA + (size_t)(t + 2) * kstep; const char* b2 = last ? nB : cB + (size_t)(t + 2) * kstep;
            const char* a3 = a2 + kstep; const char* b3 = b2 + kstep;
            PG8_LDB(B0, 0, 0); PG8_LDB(B1, 0, 1); PG8_SCHED; PG8_LDA(At, 0, 0); PG8_STAGE(PG8_SA(1, 1), a1 + hstepA, voffA);
            PG8_WAIT_V(8); PG8_WAIT_L(0); PG8_BAR; PG8_MMA(0, 0, At, B0); PG8_MMA(0, 1, At, B1); PG8_BAR; PG8_SCHED;
            PG8_LDA(At, 0, 1); PG8_STAGE(PG8_SB(0, 0), b2, voffB); PG8_STAGE(PG8_SB(0, 1), b2 + hstepB, voffB); PG8_STAGE(PG8_SA(0, 0), a2, voffA);
            PG8_WAIT_V(8); PG8_WAIT_L(0); PG8_BAR; PG8_MMA(1, 0, At, B0); PG8_MMA(1, 1, At, B1); PG8_BAR; PG8_SCHED;
            PG8_LDB(B0, 1, 0); PG8_LDB(B1, 1, 1); PG8_SCHED; PG8_LDA(At, 1, 0); PG8_STAGE(PG8_SA(0, 1), a2 + hstepA, voffA);
            PG8_WAIT_V(8); PG8_WAIT_L(0); PG8_BAR; PG8_MMA(0, 0, At, B0); PG8_MMA(0, 1, At, B1); PG8_BAR; PG8_SCHED;
            PG8_LDA(At, 1, 1); PG8_STAGE(PG8_SB(1, 0), b3, voffB); PG8_STAGE(PG8_SB(1, 1), b3 + hstepB, voffB); PG8_STAGE(PG8_SA(1, 0), a3, voffA);
            PG8_WAIT_V(8); PG8_WAIT_L(0); PG8_BAR; PG8_MMA(1, 0, At, B0); PG8_MMA(1, 1, At, B1); PG8_BAR; PG8_SCHED;
        }
        if (wr == 0) PG8_BAR;
        E(acc, cur, wr, wc, fr, fq);
        if (!has_next) break;
#pragma unroll
        for (int a = 0; a < 2; ++a)
#pragma unroll
            for (int b = 0; b < 2; ++b)
#pragma unroll
                for (int m = 0; m < 4; ++m)
#pragma unroll
                    for (int n = 0; n < 2; ++n) acc[a][b][m][n] = (f32x4){0.f, 0.f, 0.f, 0.f};
        cur = nxt; cA = nA; cB = nB; ++ui;
        if (wr == 1) PG8_BAR;
    }
    PG8_WAIT_V(0);
    PG8_BAR;
#undef PG8_SA
#undef PG8_SB
#undef PG8_STAGE
#undef PG8_LDA
#undef PG8_LDB
#undef PG8_MMA
#undef PG8_WAIT_V
#undef PG8_WAIT_L
#undef PG8_BAR
#undef PG8_SCHED
}
}
using pg8::Unit;
struct EpiRes {
    static constexpr bool PERM = false;
    const float* base0; const float* base1; float* out; const float* scale; float* part; bool dry;
    DI void operator()(const f32x4 (&acc)[2][2][4][2], const Unit& u, int wr, int wc, int fr, int fq) const {
        const int col0 = u.pn * 256 + wc * 32 + 4 * fq;
        f32x4 sc[2][2];
#pragma unroll
        for (int bj = 0; bj < 2; ++bj)
#pragma unroll
            for (int n = 0; n < 2; ++n) sc[bj][n] = scale ? *(const f32x4*)(scale + col0 + bj * 128 + n * 16) : (f32x4){1.f, 1.f, 1.f, 1.f};
        if (u.pm >= 128) {
#pragma unroll
            for (int ai = 0; ai < 2; ++ai)
#pragma unroll
                for (int m = 0; m < 4; ++m) {
                    const int row = u.pm * 256 + ai * 128 + wr * 64 + m * 16 + fr;
                    float* pp = part + ((size_t)u.k0 * MS + (row - MP)) * D;
#pragma unroll
                    for (int bj = 0; bj < 2; ++bj)
#pragma unroll
                        for (int n = 0; n < 2; ++n) { const int c = col0 + bj * 128 + n * 16; if (!dry) *(f32x4*)(pp + c) = acc[ai][bj][m][n] * sc[bj][n]; }
                }
            return;
        }
#pragma unroll
        for (int ai = 0; ai < 2; ++ai) {
            f32x4 pre[4][2][2];
#pragma unroll
            for (int m = 0; m < 4; ++m) { const float* bp = base0 + (size_t)(u.pm * 256 + ai * 128 + wr * 64 + m * 16 + fr) * D;
#pragma unroll
                for (int bj = 0; bj < 2; ++bj)
#pragma unroll
                    for (int n = 0; n < 2; ++n) pre[m][bj][n] = *(const f32x4*)(bp + col0 + bj * 128 + n * 16); }
            asm volatile("" ::: "memory");
#pragma unroll
            for (int m = 0; m < 4; ++m) { float* op = out + (size_t)(u.pm * 256 + ai * 128 + wr * 64 + m * 16 + fr) * D;
#pragma unroll
                for (int bj = 0; bj < 2; ++bj)
#pragma unroll
                    for (int n = 0; n < 2; ++n) { if (!dry) *(f32x4*)(op + col0 + bj * 128 + n * 16) = pre[m][bj][n] + acc[ai][bj][m][n] * sc[bj][n]; } }
            asm volatile("" ::: "memory");
        }
    }
};
DI float dpp_ror1(float v) { return __int_as_float(__builtin_amdgcn_mov_dpp(__float_as_int(v), 0x121, 0xf, 0xf, false)); }
DI float dpp_ror2(float v) { return __int_as_float(__builtin_amdgcn_mov_dpp(__float_as_int(v), 0x122, 0xf, 0xf, false)); }
DI float silu_f(float y) { return y * __builtin_amdgcn_rcpf(1.f + __builtin_amdgcn_exp2f(-1.4426950408889634f * y)); }
struct EpiUp {
    static constexpr bool PERM = true;
    bf16_t* H; float* SG0; float* SV0; float* SGL; float* out; const float* cw; const float* cb; int layer; const float* st;
    DI void operator()(const f32x4 (&acc)[2][2][4][2], const Unit& u, int wr, int wc, int fr, int fq) const {
        const int col = u.pn * 128 + wc * 32 + 8 * fq;
        const bool smp = (u.pm >= 128);
        const V8 w0 = v8_ldf(cw + col), w1 = v8_ldf(cw + FF + col), w2 = v8_ldf(cw + 2 * FF + col), bb = v8_ldf(cb + col);
#pragma unroll
        for (int ai = 0; ai < 2; ++ai) {
            const int seg = u.pm * 4 + ai * 2 + wr;
            f32x4 q1[2], q2[2];
#pragma unroll
            for (int m = 0; m < 4; ++m) {
                const int row = seg * 64 + m * 16 + fr;
                f32x4 hh[2];
#pragma unroll
                for (int n = 0; n < 2; ++n) {
                    const f32x4 g = acc[ai][1][m][n], v = acc[ai][0][m][n];
                    f32x4 c1, c2;
#pragma unroll
                    for (int j = 0; j < 4; ++j) { c1[j] = dpp_ror1(g[j]); c2[j] = dpp_ror2(g[j]); }
                    f32x4 p1 = c1, p2 = c2;
                    if (m == 0 && smp) {
                        const float* sp = st + ((size_t)(seg - 512) * 2) * FF + col + 4 * n; const f32x4 s0 = *(const f32x4*)sp, s1 = *(const f32x4*)(sp + FF);
#pragma unroll
                        for (int j = 0; j < 4; ++j) { p1[j] = (fr == 0) ? s1[j] : c1[j]; p2[j] = (fr == 0) ? s0[j] : ((fr == 1) ? s1[j] : c2[j]); }
                    }
                    if (m > 0) {
#pragma unroll
                        for (int j = 0; j < 4; ++j) { p1[j] = (fr == 0) ? q1[n][j] : c1[j]; p2[j] = (fr < 2) ? q2[n][j] : c2[j]; }
                    }
                    q1[n] = c1; q2[n] = c2;
                    const f32x4 ww0 = n ? w0.b : w0.a, ww1 = n ? w1.b : w1.a, ww2 = n ? w2.b : w2.a, wb = n ? bb.b : bb.a;
                    const f32x4 y = ww0 * p2 + ww1 * p1 + ww2 * g + wb;
#pragma unroll
                    for (int j = 0; j < 4; ++j) hh[n][j] = silu_f(y[j]) * v[j];
                }
                if (m == 0 && fr < 2 && !smp) {
                    float* o = SG0 + ((size_t)seg * 2 + fr) * FF + col; *(f32x4*)o = acc[ai][1][m][0]; *(f32x4*)(o + 4) = acc[ai][1][m][1];
                    float* o2 = SV0 + ((size_t)seg * 2 + fr) * FF + col; *(f32x4*)o2 = acc[ai][0][m][0]; *(f32x4*)(o2 + 4) = acc[ai][0][m][1];
                } else {
                    u32x4 w; w.x = pk2(hh[0][0], hh[0][1]); w.y = pk2(hh[0][2], hh[0][3]); w.z = pk2(hh[1][0], hh[1][1]); w.w = pk2(hh[1][2], hh[1][3]);
                    *(u32x4*)(H + (size_t)row * FF + col) = w;
                }
                if (m == 3 && fr >= 14) {
                    float* o = SGL + ((size_t)seg * 2 + (fr - 14)) * FF + col; *(f32x4*)o = acc[ai][1][m][0]; *(f32x4*)(o + 4) = acc[ai][1][m][1];
                    int s, b, t; rowinfo(row, s, b, t); const int L = s ? 64 : 4096;
                    if (t >= L - 2) { float* os = out + (s ? O_FFNS : O_FFNP) + ((size_t)(layer * 8 + b) * 2 + (t - (L - 2))) * FF + col; *(f32x4*)os = acc[ai][1][m][0]; *(f32x4*)(os + 4) = acc[ai][1][m][1]; }
                }
            }
        }
    }
};
struct EpiDnIn {
    static constexpr bool PERM = true;
    bf16_t* PRE; bf16_t* Z; float* AB; bf16_t* HALO; float* out;
    DI void operator()(const f32x4 (&acc)[2][2][4][2], const Unit& u, int wr, int wc, int fr, int fq) const {
#pragma unroll
        for (int ai = 0; ai < 2; ++ai)
#pragma unroll
            for (int m = 0; m < 4; ++m) {
                const int row = u.pm * 256 + ai * 128 + wr * 64 + m * 16 + fr;
                int s, b, t; rowinfo(row, s, b, t); const int L = s ? 64 : 4096;
#pragma unroll
                for (int bj = 0; bj < 2; ++bj) {
                    const int col = u.pn * 256 + bj * 128 + wc * 32 + 8 * fq;
                    u32x4 w; w.x = pk2(acc[ai][bj][m][0][0], acc[ai][bj][m][0][1]); w.y = pk2(acc[ai][bj][m][0][2], acc[ai][bj][m][0][3]); w.z = pk2(acc[ai][bj][m][1][0], acc[ai][bj][m][1][1]); w.w = pk2(acc[ai][bj][m][1][2], acc[ai][bj][m][1][3]);
                    if (u.pn < 12) {
                        *(u32x4*)(PRE + (size_t)row * DNQ + col) = w;
                        if ((t & 63) >= 61) *(u32x4*)(HALO + ((size_t)(row >> 6) * 3 + ((t & 63) - 61)) * DNQ + col) = w;
                        if (t >= L - 3) { float* o = out + (s ? O_DNCS : O_DNCP) + ((size_t)b * 3 + (t - (L - 3))) * DNQ + col; *(f32x4*)o = acc[ai][bj][m][0]; *(f32x4*)(o + 4) = acc[ai][bj][m][1]; }
                    } else if (u.pn < 16) {
                        *(u32x4*)(Z + (size_t)row * D + (col - DNQ)) = w;
                    } else if (bj == 0 && wc == 0 && fq < 2) {
                        float* o = AB + (size_t)row * 16 + 8 * fq; *(f32x4*)o = acc[ai][bj][m][0]; *(f32x4*)(o + 4) = acc[ai][bj][m][1];
                    }
                }
            }
    }
};
struct EpiQkv {
    static constexpr bool PERM = true;
    bf16_t* Q; bf16_t* KP; bf16_t* VTP; bf16_t* KS; bf16_t* VTS; float* out; LAS unsigned char* tl;
    DI void operator()(const f32x4 (&acc)[2][2][4][2], const Unit& u, int wr, int wc, int fr, int fq) const {
        LAS unsigned char* tw = tl + (wr * 4 + wc) * 1024; const int lane = fq * 16 + fr;
#pragma unroll
        for (int ai = 0; ai < 2; ++ai)
#pragma unroll
            for (int m = 0; m < 4; ++m) {
                const int row = u.pm * 256 + ai * 128 + wr * 64 + m * 16 + fr;
                int s, b, t; rowinfo(row, s, b, t);
#pragma unroll
                for (int bj = 0; bj < 2; ++bj) {
                    const int col = u.pn * 256 + bj * 128 + wc * 32 + 8 * fq;
                    u32x4 w; w.x = pk2(acc[ai][bj][m][0][0], acc[ai][bj][m][0][1]); w.y = pk2(acc[ai][bj][m][0][2], acc[ai][bj][m][0][3]); w.z = pk2(acc[ai][bj][m][1][0], acc[ai][bj][m][1][1]); w.w = pk2(acc[ai][bj][m][1][2], acc[ai][bj][m][1][3]);
                    if (u.pn < 4) { *(u32x4*)(Q + (size_t)row * D + col) = w; }
                    else if (u.pn < 8) {
                        const int c = col - D;
                        float* o = out + (s ? O_KS + (size_t)(row - MP) * D : O_KP + (size_t)row * D) + c; __builtin_nontemporal_store(acc[ai][bj][m][0], (f32x4*)o); __builtin_nontemporal_store(acc[ai][bj][m][1], (f32x4*)(o + 4));
                        bf16_t* kb = s ? KS + ((size_t)b * LK + PAST + t) * D + c : KP + (size_t)row * D + c; *(u32x4*)kb = w;
                    } else {
                        const int c = col - 2 * D;
                        float* o = out + (s ? O_VS + (size_t)(row - MP) * D : O_VP + (size_t)row * D) + c; __builtin_nontemporal_store(acc[ai][bj][m][0], (f32x4*)o); __builtin_nontemporal_store(acc[ai][bj][m][1], (f32x4*)(o + 4));
                        LAS bf16_t* tp = (LAS bf16_t*)tw + (8 * fq) * 16 + fr;
                        tp[0] = (bf16_t)(w.x & 0xffff); tp[16] = (bf16_t)(w.x >> 16); tp[32] = (bf16_t)(w.y & 0xffff); tp[48] = (bf16_t)(w.y >> 16);
                        tp[64] = (bf16_t)(w.z & 0xffff); tp[80] = (bf16_t)(w.z >> 16); tp[96] = (bf16_t)(w.w & 0xffff); tp[112] = (bf16_t)(w.w >> 16);
                        asm volatile("s_waitcnt lgkmcnt(0)" ::: "memory");
                        const u32x4 tv = *(const LAS u32x4*)(tw + (lane >> 1) * 32 + (lane & 1) * 16);
                        asm volatile("s_waitcnt lgkmcnt(0)" ::: "memory");
                        const int cc = (col - 8 * fq) - 2 * D + (lane >> 1), h = cc >> 6, d = cc & 63, t0 = (t - fr) + (lane & 1) * 8;
                        bf16_t* vt = s ? VTS + ((size_t)(b * 16 + h) * 64 + d) * LK + PAST + t0 : VTP + ((size_t)(b * 16 + h) * 64 + d) * 4096 + t0;
                        *(u32x4*)vt = tv;
                    }
                }
            }
    }
};

DI void cvt_item(const float* W, int ldw, int nvalid, int srccol0, bf16_t* WT, int K, int dstrow0, int k0, LAS float* scr, int lane) {
    const int n = srccol0 + (lane & 31);
#pragma unroll 8
    for (int i = 0; i < 32; ++i) { const int kk = 2 * i + (lane >> 5); scr[kk * 33 + (lane & 31)] = (n < nvalid) ? __builtin_nontemporal_load(W + (size_t)(k0 + kk) * ldw + n) : 0.f; }
    asm volatile("s_waitcnt lgkmcnt(0)" ::: "memory");
    const int c = lane & 7;
#pragma unroll
    for (int j = 0; j < 4; ++j) { const int nn = (lane >> 3) + 8 * j; const LAS float* s = scr + (8 * c) * 33 + nn;
        u32x4 o; o.x = pk2(s[0 * 33], s[1 * 33]); o.y = pk2(s[2 * 33], s[3 * 33]); o.z = pk2(s[4 * 33], s[5 * 33]); o.w = pk2(s[6 * 33], s[7 * 33]);
        *(u32x4*)(WT + (size_t)(dstrow0 + nn) * K + k0 + 8 * c) = o; }
    asm volatile("s_waitcnt lgkmcnt(0)" ::: "memory");
}
template <int MODE>
DI void cvt_matrix(const float* W, int ldw, int nvalid, int K, int Npad, bf16_t* WT, LAS float* scr, int gw, int NGW, int lane) {
    const int nblk = Npad / 32, nitems = (K / 64) * nblk;
    for (int it = gw; it < nitems; it += NGW) {
        const int kb = it / nblk, nb = it % nblk; int src0 = nb * 32;
        if (MODE == 1) { const int pn = nb >> 3, wb = nb & 7; src0 = (wb < 4) ? pn * 128 + wb * 32 : FF + pn * 128 + (wb - 4) * 32; }
        cvt_item(W, ldw, nvalid, src0, WT, K, nb * 32, kb * 64, scr, lane);
    }
}

DI void convert_layer_weights(const Params& p, int layer, LAS float* scr, int gw, int NGW, int lane) {
    cvt_matrix<1>(p.in[21] + (size_t)layer * D * NUP, NUP, NUP, D, NUP, (bf16_t*)(p.ws + w_up(layer)), scr, gw, NGW, lane);
    cvt_matrix<0>(p.in[24] + (size_t)layer * FF * D, D, D, FF, D, (bf16_t*)(p.ws + w_dn(layer)), scr, gw, NGW, lane);
    if (layer == 0 || layer == 3) {
        for (int g = 0; g < 4; ++g) cvt_matrix<0>(p.in[11] + (size_t)((layer / 3) * 4 + g) * 65536, 256, 256, 256, 256, (bf16_t*)(p.ws + w_mix(layer)) + (size_t)g * 65536, scr, gw, NGW, lane);
    } else if (layer == 1) {
        cvt_matrix<0>(p.in[13], DNIN, DNIN, D, DNINP, (bf16_t*)(p.ws + w_mix(1)), scr, gw, NGW, lane);
        cvt_matrix<0>(p.in[18], D, D, D, D, (bf16_t*)(p.ws + w_mix2(1)), scr, gw, NGW, lane);
    } else {
        cvt_matrix<0>(p.in[19], 3 * D, 3 * D, D, 3 * D, (bf16_t*)(p.ws + w_mix(2)), scr, gw, NGW, lane);
        cvt_matrix<0>(p.in[20], D, D, D, D, (bf16_t*)(p.ws + w_mix2(2)), scr, gw, NGW, lane);
    }
}

template <bool FINAL>
DI void norm_rows(const Params& p, const float* gain, int in_mode  , int npart  , int pool_j  , int gw, int NGW, int lane) {
    float* X = p.out; bf16_t* XN = (bf16_t*)(p.ws + WS_XN);
    f32x4 gv[4];
#pragma unroll
    for (int j = 0; j < 4; ++j) gv[j] = *(const f32x4*)(gain + 4 * lane + 256 * j);
    for (int row = gw; row < MA; row += NGW) {
        const float* xr = (row < MP) ? (in_mode == 1 ? p.in[0] + (size_t)row * D : X + (size_t)row * D) : (in_mode ? p.in[1] + (size_t)(row - MP) * D : X + (size_t)row * D);
        f32x4 v[4]; float s = 0.f;
#pragma unroll
        for (int j = 0; j < 4; ++j) v[j] = *(const f32x4*)(xr + 4 * lane + 256 * j);
        if (row >= MP && npart > 0) {
            const float* pp = (const float*)(p.ws + WS_PART) + (size_t)(row - MP) * D + 4 * lane;
            int k = 0;
            for (; k + 4 <= npart; k += 4) {
                f32x4 t[4][4];
#pragma unroll
                for (int kk = 0; kk < 4; ++kk)
#pragma unroll
                    for (int j = 0; j < 4; ++j) t[kk][j] = *(const f32x4*)(pp + (size_t)(k + kk) * MS * D + 256 * j);
#pragma unroll
                for (int j = 0; j < 4; ++j) v[j] += (t[0][j] + t[1][j]) + (t[2][j] + t[3][j]);
            }
            for (; k + 2 <= npart; k += 2) {
                f32x4 t[2][4];
#pragma unroll
                for (int kk = 0; kk < 2; ++kk)
#pragma unroll
                    for (int j = 0; j < 4; ++j) t[kk][j] = *(const f32x4*)(pp + (size_t)(k + kk) * MS * D + 256 * j);
#pragma unroll
                for (int j = 0; j < 4; ++j) v[j] += t[0][j] + t[1][j];
            }
            if (!FINAL) {
#pragma unroll
                for (int j = 0; j < 4; ++j) *(f32x4*)(X + (size_t)row * D + 4 * lane + 256 * j) = v[j]; }
        }
#pragma unroll
        for (int j = 0; j < 4; ++j) { s += (v[j].x * v[j].x + v[j].y * v[j].y) + (v[j].z * v[j].z + v[j].w * v[j].w); }
        const float rstd = rsqrtf(wave_sum(s) * (1.f / D) + EPS);
#pragma unroll
        for (int j = 0; j < 4; ++j) v[j] = v[j] * rstd * gv[j];
        if (FINAL) {
#pragma unroll
            for (int j = 0; j < 4; ++j) __builtin_nontemporal_store(v[j], (f32x4*)(X + (size_t)row * D + 4 * lane + 256 * j));
        } else {
#pragma unroll
            for (int j = 0; j < 4; ++j) { u32x2 w; w.x = pk2(v[j].x, v[j].y); w.y = pk2(v[j].z, v[j].w); *(u32x2*)(XN + (size_t)row * D + 4 * lane + 256 * j) = w; }
            if (pool_j >= 0) { int s2, b, t; rowinfo(row, s2, b, t); const int L = s2 ? 64 : 4096;
                if (t >= L - 15) { float* o = p.out + (s2 ? O_POOLS : O_POOLP) + ((size_t)(pool_j * 8 + b) * 15 + (t - (L - 15))) * D;
#pragma unroll
                    for (int j = 0; j < 4; ++j) *(f32x4*)(o + 4 * lane + 256 * j) = v[j]; } }
        }
    }
}

DI void sb_cache_convert(const Params& p, LAS float* scr  , int gtid, int NT, int gw, int NGW, int lane) {
    const float* ck = p.in[5]; const float* cv = p.in[6];
    bf16_t* KS = (bf16_t*)(p.ws + WS_KS); bf16_t* VTS = (bf16_t*)(p.ws + WS_VTS);
    for (int it = gtid; it < 8 * PAST * D / 8; it += NT) { const int c8 = it & 127, rp = it >> 7, b = rp >> 11, pos = rp & 2047;
        V8 v; v.a = __builtin_nontemporal_load((const f32x4*)(ck + (size_t)rp * D + c8 * 8)); v.b = __builtin_nontemporal_load((const f32x4*)(ck + (size_t)rp * D + c8 * 8 + 4)); *(u32x4*)(KS + ((size_t)b * LK + pos) * D + c8 * 8) = v8_pack(v); }
    for (int it = gw; it < 8 * 16 * 32; it += NGW) { const int pb = it & 31, h = (it >> 5) & 15, b = it >> 9, p0 = pb * 64;
#pragma unroll 8
        for (int i = 0; i < 64; ++i) scr[i * 65 + lane] = __builtin_nontemporal_load(cv + ((size_t)b * PAST + p0 + i) * D + h * 64 + lane);
        asm volatile("s_waitcnt lgkmcnt(0)" ::: "memory");
        bf16_t* dst = VTS + ((size_t)(b * 16 + h) * 64 + lane) * LK + p0;
#pragma unroll
        for (int c = 0; c < 8; ++c) { const LAS float* s = scr + (8 * c) * 65 + lane; u32x4 o; o.x = pk2(s[0], s[65]); o.y = pk2(s[130], s[195]); o.z = pk2(s[260], s[325]); o.w = pk2(s[390], s[455]); *(u32x4*)(dst + 8 * c) = o; }
        asm volatile("s_waitcnt lgkmcnt(0)" ::: "memory");
    }
}

DI void pool_diff(const Params& p, int pool_j, int gtid, int NT) {
    const bf16_t* XN = (const bf16_t*)(p.ws + WS_XN); bf16_t* Dd = (bf16_t*)(p.ws + WS_BIG);
    const float* sp = p.in[2] + (size_t)pool_j * 8 * 15 * D;
    for (int it = gtid; it < (MA / 32) * 128; it += NT) {
        const int cgp = it & 127, strip = it >> 7, row0 = strip * 32, c0 = cgp * 8, win = 2 << (c0 >> 8);
        int s, b, t0; rowinfo(row0, s, b, t0);
        const size_t seq0 = (size_t)(row0 - t0);
        V8 sum = v8zero();
#define POOL_LD(tt, dst) do { const int _t = (tt); if (_t >= 0) dst = v8_ldbf(XN + (seq0 + _t) * D + c0); else if (s) dst = v8_ldf(sp + ((size_t)b * 15 + 15 + _t) * D + c0); else dst = v8zero(); } while (0)
        for (int j = win - 1; j >= 1; --j) { V8 v; POOL_LD(t0 - j, v); sum.a += v.a; sum.b += v.b; }
        for (int r = 0; r < 32; ++r) {
            const int t = t0 + r; V8 cur; POOL_LD(t, cur); sum.a += cur.a; sum.b += cur.b;
            const float cnt = s ? (float)win : (float)((t + 1) < win ? (t + 1) : win); const float inv = 1.f / cnt;
            V8 d; d.a = sum.a * inv - cur.a; d.b = sum.b * inv - cur.b;
            *(u32x4*)(Dd + (size_t)(row0 + r) * D + c0) = v8_pack(d);
            V8 old; POOL_LD(t - win + 1, old); sum.a -= old.a; sum.b -= old.b;
        }
#undef POOL_LD
    }
}

DI void ffn_hidden(const Params& p, int layer, int gtid, int NT) {
    bf16_t* H = (bf16_t*)(p.ws + WS_V); const float* SG0 = (const float*)(p.ws + WS_SG0); const float* SV0 = (const float*)(p.ws + WS_SV0); const float* SGL = (const float*)(p.ws + WS_SGL);
    const float* cw = p.in[22] + (size_t)layer * 3 * FF; const float* cb = p.in[23] + (size_t)layer * FF; const float* st = p.in[7] + (size_t)layer * 8 * 2 * FF;
    for (int it = gtid; it < 512 * 352; it += NT) {
        const int cgp = it % 352, seg = it / 352, row0 = seg * 64, c0 = cgp * 8;
        int s, b, t0; rowinfo(row0, s, b, t0);
        const V8 w0 = v8_ldf(cw + c0), w1 = v8_ldf(cw + FF + c0), w2 = v8_ldf(cw + 2 * FF + c0), bb = v8_ldf(cb + c0);
        V8 g2, g1;
        if (t0 == 0) { if (s) { g2 = v8_ldf(st + ((size_t)b * 2 + 0) * FF + c0); g1 = v8_ldf(st + ((size_t)b * 2 + 1) * FF + c0); } else { g2 = v8zero(); g1 = v8zero(); } }
        else { g2 = v8_ldf(SGL + ((size_t)(seg - 1) * 2 + 0) * FF + c0); g1 = v8_ldf(SGL + ((size_t)(seg - 1) * 2 + 1) * FF + c0); }
#pragma unroll
        for (int r = 0; r < 2; ++r) {
            const V8 g0 = v8_ldf(SG0 + ((size_t)seg * 2 + r) * FF + c0); const V8 v = v8_ldf(SV0 + ((size_t)seg * 2 + r) * FF + c0);
            V8 y; y.a = w0.a * g2.a + w1.a * g1.a + w2.a * g0.a + bb.a; y.b = w0.b * g2.b + w1.b * g1.b + w2.b * g0.b + bb.b;
            V8 h;
#pragma unroll
            for (int e = 0; e < 4; ++e) { h.a[e] = silu_f(y.a[e]) * v.a[e]; h.b[e] = silu_f(y.b[e]) * v.b[e]; }
            *(u32x4*)(H + (size_t)(row0 + r) * FF + c0) = v8_pack(h);
            g2 = g1; g1 = g0;
        }
    }
}

DI void lds_barrier() { asm volatile("s_waitcnt lgkmcnt(0)" ::: "memory"); __builtin_amdgcn_s_barrier(); asm volatile("" ::: "memory"); }
constexpr int DN_MST = 68, DN_RST = 260;
constexpr int DN_MM = 0, DN_QS = 17408, DN_KS = 34816, DN_KBS = 52224, DN_RHS = 69632, DN_GC = 136192, DN_BETA = 136448, DN_CW = 136704;
DI void dn_intra(const Params& p, LAS unsigned char* L, int tid_in, int wave, int bid, int G, bool dry) {
    bf16_t* PRE = (bf16_t*)(p.ws + WS_PRE); bf16_t* Wb = (bf16_t*)(p.ws + WS_W); bf16_t* ATT = (bf16_t*)(p.out + O_VP);
    const bf16_t* HALO = (const bf16_t*)(p.ws + WS_HALO); const float* AB = (const float*)(p.ws + WS_AB); float* GL = (float*)(p.ws + WS_GL);
    const float* convw = p.in[14]; const float* stc = p.in[3];
    LAS float* gcs = (LAS float*)(L + DN_GC); LAS float* betas = (LAS float*)(L + DN_BETA);
    LAS float* Mm = (LAS float*)(L + DN_MM); LAS float* RHS = (LAS float*)(L + DN_RHS);
    const int h = bid & 7, ngrp = (G >> 3) > 0 ? (G >> 3) : 1;
    LAS float* CW = (LAS float*)(L + DN_CW);
    for (int i = tid_in; i < 4 * 384; i += 512) { const int j = i / 384, c = i % 384; CW[i] = convw[(size_t)j * DNQ + (c >> 7) * 1024 + h * 128 + (c & 127)]; }
    lds_barrier();
#define DN_PREFETCH(SEGX, TID) do { const int seg_ = (SEGX), row0_ = seg_ * 64; int s_, b_, t0_; rowinfo(row0_, s_, b_, t0_); const int r_ = (TID) >> 3, sub_ = (TID) & 7; \
        _Pragma("unroll") for (int part = 0; part < 3; ++part) { const int col = part * 1024 + h * 128 + sub_ * 16; \
            _Pragma("unroll") for (int j = 0; j < 4; ++j) { const int rr = r_ - 3 + j; \
                if (rr >= 0) { const bf16_t* q = PRE + (size_t)(row0_ + rr) * DNQ + col; xr[part][j][0] = *(const u32x4*)q; xr[part][j][1] = *(const u32x4*)(q + 8); } \
                else if (t0_ != 0) { const bf16_t* q = HALO + ((size_t)(seg_ - 1) * 3 + (3 + rr)) * DNQ + col; xr[part][j][0] = *(const u32x4*)q; xr[part][j][1] = *(const u32x4*)(q + 8); } \
                else if (s_) { const float* q = stc + ((size_t)b_ * 3 + (3 + rr)) * DNQ + col; xr[part][j][0] = v8_pack(v8_ldf(q)); xr[part][j][1] = v8_pack(v8_ldf(q + 8)); } \
                else { xr[part][j][0] = (u32x4){0u, 0u, 0u, 0u}; xr[part][j][1] = (u32x4){0u, 0u, 0u, 0u}; } } } } while (0)
    u32x4 xr[3][4][2];
    if ((bid >> 3) < NSEG) DN_PREFETCH(bid >> 3, tid_in);
    for (int seg = (bid >> 3); seg < NSEG; seg += ngrp) {
        if ((G >> 3) == 0 && (bid != 0)) break;
        const int u = seg * 8 + h, row0 = seg * 64;
        int s, b, t0; rowinfo(row0, s, b, t0);
        int tid = tid_in; asm volatile("" : "+v"(tid)); int lane = tid & 63;
        const int r = tid >> 3, sub = tid & 7;
        if (wave == 0) {
            const float a = AB[(size_t)(row0 + lane) * 16 + h], bq = AB[(size_t)(row0 + lane) * 16 + 8 + h];
            const float beta = 1.f / (1.f + expf(-bq));
            const float x = a + p.in[16][h]; const float spx = fmaxf(x, 0.f) + log1pf(expf(-fabsf(x)));
            float g = -expf(p.in[15][h]) * spx;
#pragma unroll
            for (int o = 1; o < 64; o <<= 1) { const float v = __shfl_up(g, o); if (lane >= o) g += v; }
            gcs[lane] = g; betas[lane] = beta;
        }
        float qv[16], kv[16], vv[16]; float rq = 0.f, rk = 0.f;
#pragma unroll
        for (int part = 0; part < 3; ++part) {
            float y[16];
#pragma unroll
            for (int e = 0; e < 16; ++e) y[e] = 0.f;
#pragma unroll
            for (int j = 0; j < 4; ++j) {
                const V8 x0 = v8_from_bf(xr[part][j][0]), x1 = v8_from_bf(xr[part][j][1]);
                const LAS float* wq = CW + j * 384 + part * 128 + sub * 16;
                const f32x4 wa = *(const LAS f32x4*)wq, wb = *(const LAS f32x4*)(wq + 4), wc = *(const LAS f32x4*)(wq + 8), wd = *(const LAS f32x4*)(wq + 12);
#pragma unroll
                for (int e = 0; e < 4; ++e) { y[e] += wa[e] * x0.a[e]; y[4 + e] += wb[e] * x0.b[e]; y[8 + e] += wc[e] * x1.a[e]; y[12 + e] += wd[e] * x1.b[e]; }
            }
            float ss = 0.f;
#pragma unroll
            for (int e = 0; e < 16; ++e) { y[e] = silu_f(y[e]); ss += y[e] * y[e]; }
            if (part < 2) { ss += __shfl_xor(ss, 1); ss += __shfl_xor(ss, 2); ss += __shfl_xor(ss, 4); }
            if (part == 0) { rq = rsqrtf(ss + EPS) * 0.08838834764831845f;
#pragma unroll
                for (int e = 0; e < 16; ++e) qv[e] = y[e] * rq; }
            else if (part == 1) { rk = rsqrtf(ss + EPS);
#pragma unroll
                for (int e = 0; e < 16; ++e) kv[e] = y[e] * rk; }
            else {
#pragma unroll
                for (int e = 0; e < 16; ++e) vv[e] = y[e]; }
        }
        lds_barrier();
        const float beta = betas[r], gcr = gcs[r], gl = gcs[63];
        { u32x4 w0, w1; w0.x = pk2(qv[0], qv[1]); w0.y = pk2(qv[2], qv[3]); w0.z = pk2(qv[4], qv[5]); w0.w = pk2(qv[6], qv[7]); w1.x = pk2(qv[8], qv[9]); w1.y = pk2(qv[10], qv[11]); w1.z = pk2(qv[12], qv[13]); w1.w = pk2(qv[14], qv[15]);
          *(LAS u32x4*)(L + DN_QS + r * 272 + sub * 32) = w0; *(LAS u32x4*)(L + DN_QS + r * 272 + sub * 32 + 16) = w1;
          w0.x = pk2(kv[0], kv[1]); w0.y = pk2(kv[2], kv[3]); w0.z = pk2(kv[4], kv[5]); w0.w = pk2(kv[6], kv[7]); w1.x = pk2(kv[8], kv[9]); w1.y = pk2(kv[10], kv[11]); w1.z = pk2(kv[12], kv[13]); w1.w = pk2(kv[14], kv[15]);
          *(LAS u32x4*)(L + DN_KS + r * 272 + sub * 32) = w0; *(LAS u32x4*)(L + DN_KS + r * 272 + sub * 32 + 16) = w1;
          w0.x = pk2(kv[0] * beta, kv[1] * beta); w0.y = pk2(kv[2] * beta, kv[3] * beta); w0.z = pk2(kv[4] * beta, kv[5] * beta); w0.w = pk2(kv[6] * beta, kv[7] * beta);
          w1.x = pk2(kv[8] * beta, kv[9] * beta); w1.y = pk2(kv[10] * beta, kv[11] * beta); w1.z = pk2(kv[12] * beta, kv[13] * beta); w1.w = pk2(kv[14] * beta, kv[15] * beta);
          *(LAS u32x4*)(L + DN_KBS + r * 272 + sub * 32) = w0; *(LAS u32x4*)(L + DN_KBS + r * 272 + sub * 32 + 16) = w1;
          const float kb = beta * __expf(gcr);
#pragma unroll
          for (int e4 = 0; e4 < 4; ++e4) { *(LAS f32x4*)(RHS + r * DN_RST + 128 + sub * 16 + e4 * 4) = (f32x4){kv[4 * e4] * kb, kv[4 * e4 + 1] * kb, kv[4 * e4 + 2] * kb, kv[4 * e4 + 3] * kb};
              *(LAS f32x4*)(RHS + r * DN_RST + sub * 16 + e4 * 4) = (f32x4){vv[4 * e4] * beta, vv[4 * e4 + 1] * beta, vv[4 * e4 + 2] * beta, vv[4 * e4 + 3] * beta}; } }
        lds_barrier();
        asm volatile("" : "+v"(tid)); lane = tid & 63;
        { const float eq = __expf(gcr), ek = __expf(gl - gcr);
          u32x4 w0, w1; w0.x = pk2(qv[0] * eq, qv[1] * eq); w0.y = pk2(qv[2] * eq, qv[3] * eq); w0.z = pk2(qv[4] * eq, qv[5] * eq); w0.w = pk2(qv[6] * eq, qv[7] * eq);
          w1.x = pk2(qv[8] * eq, qv[9] * eq); w1.y = pk2(qv[10] * eq, qv[11] * eq); w1.z = pk2(qv[12] * eq, qv[13] * eq); w1.w = pk2(qv[14] * eq, qv[15] * eq);
          bf16_t* q = PRE + (size_t)(row0 + r) * DNQ + h * 128 + sub * 16; if (!dry) { *(u32x4*)q = w0; *(u32x4*)(q + 8) = w1; }
          w0.x = pk2(kv[0] * ek, kv[1] * ek); w0.y = pk2(kv[2] * ek, kv[3] * ek); w0.z = pk2(kv[4] * ek, kv[5] * ek); w0.w = pk2(kv[6] * ek, kv[7] * ek);
          w1.x = pk2(kv[8] * ek, kv[9] * ek); w1.y = pk2(kv[10] * ek, kv[11] * ek); w1.z = pk2(kv[12] * ek, kv[13] * ek); w1.w = pk2(kv[14] * ek, kv[15] * ek);
          if (!dry) { *(u32x4*)(q + 1024) = w0; *(u32x4*)(q + 1024 + 8) = w1; }
          if (tid == 0) GL[u] = __expf(gl); }
        asm volatile("" : "+v"(tid)); lane = tid & 63;
        { const int which = wave >> 2, blk = wave & 3, ib = blk >> 1, jb = blk & 1, n31 = lane & 31, hi = lane >> 5;
          f32x16 c;
#pragma unroll
          for (int e = 0; e < 16; ++e) c[e] = 0.f;
          if (!(ib == 0 && jb == 1)) {
              const int abase = (which ? DN_QS : DN_KBS) + (ib * 32 + n31) * 272 + hi * 16, bbase = DN_KS + (jb * 32 + n31) * 272 + hi * 16;
#pragma unroll
              for (int ks = 0; ks < 8; ++ks) { const bf16x8 a = *(const LAS bf16x8*)(L + abase + ks * 32); const bf16x8 bb = *(const LAS bf16x8*)(L + bbase + ks * 32); c = MFMA32(a, bb, c); }
          }
          const int j = jb * 32 + n31; const float gj = gcs[j];
#pragma unroll
          for (int e = 0; e < 16; ++e) { const int i = ib * 32 + crow(e, hi); const float dec = __expf(gcs[i] - gj);
              if (which == 0) Mm[i * DN_MST + j] = (i > j) ? c[e] * dec : 0.f;
              else if (!dry) ATT[(size_t)u * 4096 + i * 64 + j] = f2bf((i >= j) ? c[e] * dec : 0.f); }
        }
        lds_barrier();
        asm volatile("" : "+v"(tid)); lane = tid & 63;
        asm volatile("" : "+v"(tid));
        if (seg + ngrp < NSEG) DN_PREFETCH(seg + ngrp, tid);
        if (tid < 256) {
            float x[32];
#pragma unroll
            for (int i = 0; i < 32; ++i) {
                float a = RHS[i * DN_RST + tid];
#pragma unroll
                for (int j4 = 0; j4 < (i + 3) / 4; ++j4) { const f32x4 m4 = *(const LAS f32x4*)(Mm + i * DN_MST + 4 * j4);
#pragma unroll
                    for (int e = 0; e < 4; ++e) if (4 * j4 + e < i) a -= m4[e] * x[4 * j4 + e]; }
                x[i] = a; RHS[i * DN_RST + tid] = a; if ((i & 1) == 1) __builtin_amdgcn_sched_barrier(0);
            }
        }
        lds_barrier();
        { asm volatile("" : "+v"(tid)); lane = tid & 63; const int n31 = lane & 31, hi = lane >> 5;
          f32x16 c;
#pragma unroll
          for (int e = 0; e < 16; ++e) c[e] = 0.f;
#pragma unroll
          for (int ks = 0; ks < 16; ++ks) { const float av = Mm[(32 + n31) * DN_MST + 2 * ks + hi]; const float bv = RHS[(2 * ks + hi) * DN_RST + wave * 32 + n31]; c = __builtin_amdgcn_mfma_f32_32x32x2f32(av, bv, c, 0, 0, 0); }
#pragma unroll
          for (int e = 0; e < 16; ++e) { LAS float* q = RHS + (32 + crow(e, hi)) * DN_RST + wave * 32 + n31; *q = *q - c[e]; } }
        lds_barrier();
        asm volatile("" : "+v"(tid)); lane = tid & 63;
        if (tid < 256) {
            float x[32];
#pragma unroll
            for (int i = 0; i < 32; ++i) {
                float a = RHS[(32 + i) * DN_RST + tid];
#pragma unroll
                for (int j4 = 0; j4 < (i + 3) / 4; ++j4) { const f32x4 m4 = *(const LAS f32x4*)(Mm + (32 + i) * DN_MST + 32 + 4 * j4);
#pragma unroll
                    for (int e = 0; e < 4; ++e) if (4 * j4 + e < i) a -= m4[e] * x[4 * j4 + e]; }
                x[i] = a; RHS[(32 + i) * DN_RST + tid] = a; if ((i & 1) == 1) __builtin_amdgcn_sched_barrier(0);
            }
        }
        lds_barrier();
        asm volatile("" : "+v"(tid));
        for (int it = tid; it < 64 * 32; it += 512) {
            const int i = it >> 5, c8 = it & 31;
            const f32x4 a = *(const LAS f32x4*)(RHS + i * DN_RST + c8 * 8), bq = *(const LAS f32x4*)(RHS + i * DN_RST + c8 * 8 + 4);
            u32x4 w;
            if (dry) continue;
            if (c8 < 16) { w.x = pk2(a.x, a.y); w.y = pk2(a.z, a.w); w.z = pk2(bq.x, bq.y); w.w = pk2(bq.z, bq.w); *(u32x4*)(PRE + (size_t)(row0 + i) * DNQ + 2048 + h * 128 + c8 * 8) = w; }
            else { w.x = pk2(-a.x, -a.y); w.y = pk2(-a.z, -a.w); w.z = pk2(-bq.x, -bq.y); w.w = pk2(-bq.z, -bq.w); *(u32x4*)(Wb + (size_t)(row0 + i) * D + h * 128 + (c8 - 16) * 8) = w; }
        }
        lds_barrier();
    }
}

constexpr int SC_W = 0, SC_QG = 17408, SC_AT = 34816, SC_KGT = 44032, SC_U = 62464, SC_ST = 79872, SC_VNT = 114688;
DI void dn_scan(const Params& p, LAS unsigned char* L, int tid, int wave, int lane, int bid, int G) {
    const int w = bid;
    if (w >= 128) {
        if (G > 128) { LAS float* scr = (LAS float*)(L + wave * 16640); const int gw2 = (w - 128) * 8 + wave, NGW2 = (G - 128) * 8;
            convert_layer_weights(p, 2, scr, gw2, NGW2, lane); convert_layer_weights(p, 3, scr, gw2, NGW2, lane);
            sb_cache_convert(p, scr, (w - 128) * 512 + tid, (G - 128) * 512, gw2, NGW2, lane); }
        return;
    }
    const int strm = w >> 6, b = (w & 63) >> 3, h = w & 7, nsteps = strm ? 1 : 64, seg0 = strm ? 512 + b : b * 64;
    const bf16_t* PRE = (const bf16_t*)(p.ws + WS_PRE); const bf16_t* Wb = (const bf16_t*)(p.ws + WS_W); const bf16_t* ATT = (const bf16_t*)(p.out + O_VP); const float* GL = (const float*)(p.ws + WS_GL); bf16_t* XNo = (bf16_t*)(p.ws + WS_XN);
    const int n31 = lane & 31, hi = lane >> 5, ib = wave >> 2, db = wave & 3;
    f32x16 sacc[2];
    { const float* S0 = p.in[4] + (size_t)(b * 8 + h) * 16384;
#pragma unroll
      for (int k2 = 0; k2 < 2; ++k2) { const int kb = ib * 2 + k2;
#pragma unroll
          for (int e = 0; e < 16; ++e) sacc[k2][e] = strm ? S0[(kb * 32 + crow(e, hi)) * 128 + db * 32 + n31] : 0.f; } }
    u32x4 rW[2], rQ[2], rK[2], rU[2], rA;
#define SC_LOAD(c) do { const int _row0 = (seg0 + (c)) * 64; _Pragma("unroll") for (int k = 0; k < 2; ++k) { const int id = tid + 512 * k, rr = id >> 4, c16 = id & 15; \
        rW[k] = *(const u32x4*)(Wb + (size_t)(_row0 + rr) * D + h * 128 + c16 * 8); const bf16_t* q = PRE + (size_t)(_row0 + rr) * DNQ + h * 128 + c16 * 8; \
        rQ[k] = *(const u32x4*)q; rU[k] = *(const u32x4*)(q + 2048); \
        rK[k] = *(const u32x4*)(PRE + (size_t)(_row0 + (id & 63)) * DNQ + 1024 + h * 128 + (id >> 6) * 8); }   \
        rA = *(const u32x4*)(ATT + (size_t)((seg0 + (c)) * 8 + h) * 4096 + (tid >> 3) * 64 + (tid & 7) * 8); } while (0)
#define SC_STORE() do { _Pragma("unroll") for (int k = 0; k < 2; ++k) { const int id = tid + 512 * k, rr = id >> 4, c16 = id & 15; \
        *(LAS u32x4*)(L + SC_W + rr * 272 + c16 * 16) = rW[k]; *(LAS u32x4*)(L + SC_QG + rr * 272 + c16 * 16) = rQ[k]; *(LAS u32x4*)(L + SC_U + rr * 272 + c16 * 16) = rU[k]; \
        LAS bf16_t* kt = (LAS bf16_t*)(L + SC_KGT) + ((id >> 6) * 8) * 72 + (id & 63); \
        kt[0] = (bf16_t)(rK[k].x & 0xffff); kt[72] = (bf16_t)(rK[k].x >> 16); kt[144] = (bf16_t)(rK[k].y & 0xffff); kt[216] = (bf16_t)(rK[k].y >> 16); \
        kt[288] = (bf16_t)(rK[k].z & 0xffff); kt[360] = (bf16_t)(rK[k].z >> 16); kt[432] = (bf16_t)(rK[k].w & 0xffff); kt[504] = (bf16_t)(rK[k].w >> 16); } \
        *(LAS u32x4*)(L + SC_AT + (tid >> 3) * 144 + (tid & 7) * 16) = rA; } while (0)
#define SC_WRITE_ST() do { _Pragma("unroll") for (int k2 = 0; k2 < 2; ++k2) { const int kb = ib * 2 + k2; _Pragma("unroll") for (int g = 0; g < 4; ++g) { u32x2 w2; w2.x = pk2(sacc[k2][4 * g], sacc[k2][4 * g + 1]); w2.y = pk2(sacc[k2][4 * g + 2], sacc[k2][4 * g + 3]); \
        *(LAS u32x2*)(L + SC_ST + (db * 32 + n31) * 272 + (kb * 32 + 8 * g + 4 * hi) * 2) = w2; } } } while (0)
    SC_LOAD(0); SC_STORE(); SC_WRITE_ST();
    float glast_n = GL[seg0 * 8 + h];
    lds_barrier();
    for (int c = 0; c < nsteps; ++c) {
        const int row0 = (seg0 + c) * 64; const float glast = glast_n;
        if (c + 1 < nsteps) { SC_LOAD(c + 1); glast_n = GL[(seg0 + c + 1) * 8 + h]; }
        f32x16 vacc, oacc;
#pragma unroll
        for (int e = 0; e < 16; ++e) { vacc[e] = bf2f(*(const LAS bf16_t*)(L + SC_U + (ib * 32 + crow(e, hi)) * 272 + (db * 32 + n31) * 2)); oacc[e] = 0.f; }
#pragma unroll 2
        for (int ks = 0; ks < 8; ++ks) {
            const bf16x8 bs = *(const LAS bf16x8*)(L + SC_ST + (db * 32 + n31) * 272 + ks * 32 + hi * 16);
            const bf16x8 aw = *(const LAS bf16x8*)(L + SC_W + (ib * 32 + n31) * 272 + ks * 32 + hi * 16);
            const bf16x8 aq = *(const LAS bf16x8*)(L + SC_QG + (ib * 32 + n31) * 272 + ks * 32 + hi * 16);
            vacc = MFMA32(aw, bs, vacc); oacc = MFMA32(aq, bs, oacc);
        }
#pragma unroll
        for (int g = 0; g < 4; ++g) { u32x2 w2; w2.x = pk2(vacc[4 * g], vacc[4 * g + 1]); w2.y = pk2(vacc[4 * g + 2], vacc[4 * g + 3]);
            *(LAS u32x2*)(L + SC_VNT + (db * 32 + n31) * 144 + (ib * 32 + 8 * g + 4 * hi) * 2) = w2; }
        lds_barrier();
#pragma unroll
        for (int ks = 0; ks < 4; ++ks) {
            const bf16x8 bv = *(const LAS bf16x8*)(L + SC_VNT + (db * 32 + n31) * 144 + ks * 32 + hi * 16);
            const bf16x8 aa = *(const LAS bf16x8*)(L + SC_AT + (ib * 32 + n31) * 144 + ks * 32 + hi * 16);
            oacc = MFMA32(aa, bv, oacc);
        }
#pragma unroll
        for (int k2 = 0; k2 < 2; ++k2) { const int kb = ib * 2 + k2;
#pragma unroll
            for (int e = 0; e < 16; ++e) sacc[k2][e] *= glast;
#pragma unroll
            for (int ks = 0; ks < 4; ++ks) {
                const bf16x8 bv = *(const LAS bf16x8*)(L + SC_VNT + (db * 32 + n31) * 144 + ks * 32 + hi * 16);
                const bf16x8 ak = *(const LAS bf16x8*)(L + SC_KGT + (kb * 32 + n31) * 144 + ks * 32 + hi * 16);
                sacc[k2] = MFMA32(ak, bv, sacc[k2]);
            } }
        lds_barrier();
        SC_WRITE_ST();
        if (c + 1 < nsteps) SC_STORE();
#pragma unroll
        for (int e = 0; e < 16; ++e) XNo[(size_t)(row0 + ib * 32 + crow(e, hi)) * D + h * 128 + db * 32 + n31] = f2bf(oacc[e]);
        lds_barrier();
    }
    { float* So = p.out + (strm ? O_DNS : O_DNP) + (size_t)(b * 8 + h) * 16384;
#pragma unroll
      for (int k2 = 0; k2 < 2; ++k2) { const int kb = ib * 2 + k2;
#pragma unroll
          for (int e = 0; e < 16; ++e) So[(kb * 32 + crow(e, hi)) * 128 + db * 32 + n31] = sacc[k2][e]; } }
#undef SC_LOAD
#undef SC_STORE
#undef SC_WRITE_ST
}

DI void dn_outnorm(const Params& p, int gw, int NGW, int lane) {
    const bf16_t* Z = (const bf16_t*)(p.out + O_KP); bf16_t* XN = (bf16_t*)(p.ws + WS_XN);
    const float* nw = p.in[17] + (lane & 7) * 16; const V8 n0 = v8_ldf(nw), n1 = v8_ldf(nw + 8);
    for (int row = gw; row < MA; row += NGW) {
        const bf16_t* o = XN + (size_t)row * D + lane * 16; const V8 o0 = v8_ldbf(o), o1 = v8_ldbf(o + 8);
        const bf16_t* z = Z + (size_t)row * D + lane * 16; const V8 z0 = v8_ldbf(z), z1 = v8_ldbf(z + 8);
        float ss = 0.f;
#pragma unroll
        for (int e = 0; e < 4; ++e) ss += o0.a[e] * o0.a[e] + o0.b[e] * o0.b[e] + o1.a[e] * o1.a[e] + o1.b[e] * o1.b[e];
        ss += __shfl_xor(ss, 1); ss += __shfl_xor(ss, 2); ss += __shfl_xor(ss, 4);
        const float rstd = rsqrtf(ss * (1.f / 128.f) + EPS);
        V8 r0, r1;
#pragma unroll
        for (int e = 0; e < 4; ++e) { r0.a[e] = o0.a[e] * rstd * n0.a[e] * silu_f(z0.a[e]); r0.b[e] = o0.b[e] * rstd * n0.b[e] * silu_f(z0.b[e]);
            r1.a[e] = o1.a[e] * rstd * n1.a[e] * silu_f(z1.a[e]); r1.b[e] = o1.b[e] * rstd * n1.b[e] * silu_f(z1.b[e]); }
        bf16_t* d = XN + (size_t)row * D + lane * 16; *(u32x4*)d = v8_pack(r0); *(u32x4*)(d + 8) = v8_pack(r1);
    }
}

DI void sb_attention(const Params& p, int gw, int NGW, int lane) {
    const bf16_t* Q = (const bf16_t*)(p.ws + WS_Q); bf16_t* O = (bf16_t*)(p.ws + WS_XN);
    const int n31 = lane & 31, hi = lane >> 5;
    for (int item = gw; item < 16384 + 256; item += NGW) {
        int b, h, q0, kb_start, Lrow; size_t qrow0; const bf16_t* Kb; const bf16_t* VT;
        if (item < 16384) { b = item >> 11; h = (item >> 7) & 15; const int strip = item & 127; q0 = strip * 32; qrow0 = (size_t)b * 4096 + q0; kb_start = strip; Lrow = 4096;
            Kb = (const bf16_t*)(p.ws + WS_KP) + (size_t)b * 4096 * D + h * 64; VT = (const bf16_t*)(p.ws + WS_VTP) + (size_t)(b * 16 + h) * 64 * 4096; }
        else { const int it = item - 16384; b = it >> 5; h = (it >> 1) & 15; const int strip = it & 1; q0 = strip * 32; qrow0 = (size_t)MP + b * 64 + q0; kb_start = 64 + strip; Lrow = LK;
            Kb = (const bf16_t*)(p.ws + WS_KS) + (size_t)b * LK * D + h * 64; VT = (const bf16_t*)(p.ws + WS_VTS) + (size_t)(b * 16 + h) * 64 * LK; }
        bf16x8 qf[4];
#pragma unroll
        for (int d0 = 0; d0 < 4; ++d0) qf[d0] = *(const bf16x8*)(Q + (qrow0 + n31) * D + h * 64 + d0 * 16 + hi * 8);
        f32x16 oacc[2];
#pragma unroll
        for (int e = 0; e < 16; ++e) { oacc[0][e] = 0.f; oacc[1][e] = 0.f; }
        float R = 0.f;
        for (int kb = kb_start; kb >= 0; --kb) {
            const int key0 = kb * 32; const bool diag = (kb == kb_start);
            f32x16 c;
#pragma unroll
            for (int e = 0; e < 16; ++e) c[e] = 0.f;
#pragma unroll
            for (int d0 = 0; d0 < 4; ++d0) { const bf16x8 kf = *(const bf16x8*)(Kb + (size_t)(key0 + n31) * D + d0 * 16 + hi * 8); c = MFMA32(kf, qf[d0], c); }
            u32x2 vlo[2][2], vhi[2][2];
#pragma unroll
            for (int s2 = 0; s2 < 2; ++s2)
#pragma unroll
                for (int dblk = 0; dblk < 2; ++dblk) { const bf16_t* vp = VT + (size_t)(dblk * 32 + n31) * Lrow + key0 + 16 * s2 + 4 * hi; vlo[s2][dblk] = *(const u32x2*)vp; vhi[s2][dblk] = *(const u32x2*)(vp + 8); }
            float sp[16], ls[16];
#pragma unroll
            for (int e = 0; e < 16; ++e) {
                const float z = c[e] * 0.125f; const float az = fabsf(z);
                const float l = __builtin_amdgcn_logf(1.f + __builtin_amdgcn_exp2f(-az * 1.4426950408889634f)) * 0.6931471805599453f;
                const bool valid = !diag || (crow(e, hi) < n31);
                sp[e] = valid ? fmaxf(z, 0.f) + l : 0.f; ls[e] = valid ? fminf(z, 0.f) - l : -1e30f;
            }
            float Town[4], Toth[4];
#pragma unroll
            for (int g = 0; g < 4; ++g) { Town[g] = (sp[4 * g] + sp[4 * g + 1]) + (sp[4 * g + 2] + sp[4 * g + 3]); Toth[g] = __shfl_xor(Town[g], 32); }
            float suf = R;
            float pa[16];
#pragma unroll
            for (int g = 3; g >= 0; --g) {
                const float base = suf + (hi == 0 ? Toth[g] : 0.f);
                const float r3 = base, r2 = r3 + sp[4 * g + 3], r1 = r2 + sp[4 * g + 2], r0 = r1 + sp[4 * g + 1];
                pa[4 * g + 3] = __builtin_amdgcn_exp2f((ls[4 * g + 3] - r3) * 1.4426950408889634f);
                pa[4 * g + 2] = __builtin_amdgcn_exp2f((ls[4 * g + 2] - r2) * 1.4426950408889634f);
                pa[4 * g + 1] = __builtin_amdgcn_exp2f((ls[4 * g + 1] - r1) * 1.4426950408889634f);
                pa[4 * g + 0] = __builtin_amdgcn_exp2f((ls[4 * g + 0] - r0) * 1.4426950408889634f);
                suf += Town[g] + Toth[g];
            }
            R = suf;
#pragma unroll
            for (int s2 = 0; s2 < 2; ++s2) {
                u32x4 pw; pw.x = pk2(pa[8 * s2], pa[8 * s2 + 1]); pw.y = pk2(pa[8 * s2 + 2], pa[8 * s2 + 3]); pw.z = pk2(pa[8 * s2 + 4], pa[8 * s2 + 5]); pw.w = pk2(pa[8 * s2 + 6], pa[8 * s2 + 7]);
                const bf16x8 pb = __builtin_bit_cast(bf16x8, pw);
#pragma unroll
                for (int dblk = 0; dblk < 2; ++dblk) { u32x4 vw; vw.x = vlo[s2][dblk].x; vw.y = vlo[s2][dblk].y; vw.z = vhi[s2][dblk].x; vw.w = vhi[s2][dblk].y;
                    oacc[dblk] = MFMA32(__builtin_bit_cast(bf16x8, vw), pb, oacc[dblk]); }
            }
            if (__all(R > 104.f)) break;
        }
#pragma unroll
        for (int dblk = 0; dblk < 2; ++dblk)
#pragma unroll
            for (int g = 0; g < 4; ++g) { u32x2 w2; w2.x = pk2(oacc[dblk][4 * g], oacc[dblk][4 * g + 1]); w2.y = pk2(oacc[dblk][4 * g + 2], oacc[dblk][4 * g + 3]);
                *(u32x2*)(O + (qrow0 + n31) * D + h * 64 + dblk * 32 + 8 * g + 4 * hi) = w2; }
    }
}

#define XB_TMO      128
#define XB_XCNT(j)  (256  + 64 * (j))
#define XB_XSUB(j)  (1280 + 64 * (j))
#define XB_XGEN(j)  (2304 + 64 * (j))
#define XB_TOP      3328
#define XB_TOPGEN   3392
#define XCD_BAR_WORDS 3456
#define XB_SPIN_CAP (1u << 18)

__device__ __forceinline__ unsigned xb_ld(unsigned* p)              { return __hip_atomic_load(p, __ATOMIC_RELAXED, __HIP_MEMORY_SCOPE_AGENT); }
__device__ __forceinline__ unsigned xb_add(unsigned* p, unsigned v) { return __hip_atomic_fetch_add(p, v, __ATOMIC_RELAXED, __HIP_MEMORY_SCOPE_AGENT); }
__device__ __forceinline__ unsigned xb_xcc_id() { return (unsigned)__builtin_amdgcn_s_getreg((3 << 11) | 20) & 0xFu; }
#define XB_SPIN(cond, bar) do { unsigned _sp = 0; while (cond) { __builtin_amdgcn_s_sleep(1); \
    if ((++_sp & 255u) == 0u) { if (xb_ld(&(bar)[XB_TMO])) break; if (_sp > XB_SPIN_CAP) { atomicAdd(&(bar)[XB_TMO], 1u); break; } } } } while (0)

struct XcdBarrier {
    unsigned* bar; unsigned x;
    volatile LAS unsigned* st;
};

__device__ __forceinline__ XcdBarrier xcd_barrier_post(unsigned* bar, volatile LAS unsigned* st) {
    XcdBarrier b; b.bar = bar; b.x = xb_xcc_id(); b.st = st;
    if (threadIdx.x == 0) (void)xb_add(&bar[XB_XCNT(b.x)], 1u);
    return b;
}
__device__ __forceinline__ void xcd_barrier_complete(unsigned* bar, unsigned x, unsigned& nloc, unsigned& nx) {
    const unsigned G = gridDim.x * gridDim.y * gridDim.z;
    unsigned sum, cnt, mine, sp = 0u;
    for (;;) {
        sum = 0u; cnt = 0u; mine = 0u;
#pragma unroll
        for (unsigned j = 0; j < 16; ++j) { const unsigned c = xb_ld(&bar[XB_XCNT(j)]); sum += c; cnt += (c > 0u) ? 1u : 0u; mine = (j == x) ? c : mine; }
        if (sum == G) break;
        __builtin_amdgcn_s_sleep(1);
        if ((++sp & 255u) == 0u) { if (xb_ld(&bar[XB_TMO])) break; if (sp > XB_SPIN_CAP) { atomicAdd(&bar[XB_TMO], 1u); break; } }
    }
    nloc = mine > 0u ? mine : 1u; nx = cnt > 0u ? cnt : 1u;
}

__device__ __forceinline__ void xcd_barrier(const XcdBarrier& b) {
    asm volatile("s_waitcnt vmcnt(0)" ::: "memory");
    __syncthreads();
    if (threadIdx.x == 0) {
        unsigned* bar = b.bar;
        __builtin_amdgcn_s_waitcnt(0);
        unsigned nloc = b.st[0], nx = b.st[1];
        if (nloc == 0u) { xcd_barrier_complete(bar, b.x, nloc, nx); b.st[0] = nloc; b.st[1] = nx; }
        const unsigned old = xb_add(&bar[XB_XSUB(b.x)], 1u);
        const unsigned gen = old / nloc;
        if (old + 1u == (gen + 1u) * nloc) {
            __builtin_amdgcn_fence(__ATOMIC_RELEASE, "agent");
            asm volatile("s_waitcnt vmcnt(0)" ::: "memory");
            const unsigned og = xb_add(&bar[XB_TOP], 1u);
            const unsigned tg = og / nx;
            if (og + 1u == (tg + 1u) * nx) xb_add(&bar[XB_TOPGEN], 1u);
            else XB_SPIN(xb_ld(&bar[XB_TOPGEN]) == tg, bar);
            __builtin_amdgcn_fence(__ATOMIC_ACQUIRE, "agent");
            xb_add(&bar[XB_XGEN(b.x)], 1u);
            asm volatile("s_waitcnt vmcnt(0)" ::: "memory");
        } else {
            XB_SPIN(xb_ld(&bar[XB_XGEN(b.x)]) == gen, bar);
            __builtin_amdgcn_fence(__ATOMIC_ACQUIRE, "agent");
            asm volatile("s_waitcnt vmcnt(0)" ::: "memory");
        }
    }
    __syncthreads();
}


enum { T_A = 0, T_PD, T_GMIX, T_GDNIN, T_DN2, T_DN3, T_DN4, T_GQKV, T_ATT, T_NF, T_GUP, T_GDOWN, T_FINAL };
constexpr int N_PHASES = 29;
DI void decode_phase(int ph, int& type, int& layer) {
    int k;
    if (ph < 6) { layer = 0; k = ph; } else if (ph < 15) { layer = 1; k = ph - 6; } else if (ph < 22) { layer = 2; k = ph - 15; } else if (ph < 28) { layer = 3; k = ph - 22; } else { layer = 4; type = T_FINAL; return; }
    if (k == 0) { type = T_A; return; }
    const int nm = (layer == 1) ? 6 : (layer == 2 ? 4 : 3);
    if (k >= nm) { type = T_NF + (k - nm); return; }
    if (layer == 1) { type = (k == 1) ? T_GDNIN : (k == 2) ? T_DN2 : (k == 3) ? T_DN3 : (k == 4) ? T_DN4 : T_GMIX; }
    else if (layer == 2) { type = (k == 1) ? T_GQKV : (k == 2) ? T_ATT : T_GMIX; }
    else { type = (k == 1) ? T_PD : T_GMIX; }
}

__global__ void __launch_bounds__(512, 2) mega_fwd(Params p0) {
    extern __shared__ __attribute__((aligned(16))) unsigned char lds_raw[];
    LAS unsigned char* L = (LAS unsigned char*)lds_raw;
    const int tid0 = threadIdx.x, wave0 = __builtin_amdgcn_readfirstlane(tid0 >> 6);
    const int G = gridDim.x, NGW = G * 8, NT = G * 512;
    volatile LAS unsigned* xb_st = (volatile LAS unsigned*)(L + LDS_BYTES - 64);
    if (tid0 < 2) xb_st[tid0] = 0u;
    __syncthreads();
    XcdBarrier bar = xcd_barrier_post((unsigned*)(p0.ws + WS_CTL), xb_st);
    if (p0.lo < 0) cg::this_grid().sync();
    for (int ph = p0.lo; ph < p0.hi; ++ph) {
        int type, layer; decode_phase(ph, type, layer);
#define P_LAUNDER int tid = tid0, wave = wave0, bid = blockIdx.x; asm volatile("" : "+v"(tid), "+s"(wave), "+s"(bid)); const int lane = tid & 63, gw = bid * 8 + wave, gtid = bid * 512 + tid; (void)lane; (void)gw; (void)gtid; Params p = p0; { unsigned char* w_ = p0.ws; float* o_ = p0.out; asm volatile("" : "+s"(w_), "+s"(o_)); p.ws = w_; p.out = o_; } bf16_t* XN = (bf16_t*)(p.ws + WS_XN); (void)XN
#ifndef PH_MASK
#define PH_MASK 0xffffffffu
#endif
#define EN(t) ((PH_MASK >> (t)) & 1u)
#ifndef REPMASK
#define REPMASK 0u
#endif
        const int reps = ((REPMASK >> type) & 1u) ? 2 : 1;
        for (int rp = 0; rp < reps; ++rp) {
        switch (type) {
        case T_A: if (EN(T_A)) { P_LAUNDER;
            LAS float* scr = (LAS float*)(L + wave * 16640);
            if (layer == 0 || (layer == 1 && G <= 44)) convert_layer_weights(p, layer, scr, gw, NGW, lane);
            if (layer == 2 && G <= 128) sb_cache_convert(p, scr, gtid, NT, gw, NGW, lane);
            norm_rows<false>(p, p.in[8] + (size_t)layer * D, layer == 0 ? 1 : 0, layer == 0 ? 0 : FF / 128, (layer == 0 || layer == 3) ? layer / 3 : -1, gw, NGW, lane);
        } break;
        case T_PD: if (EN(T_PD)) { P_LAUNDER; pool_diff(p, layer / 3, gtid, NT); } break;
        case T_GMIX: case T_GDOWN: if (EN(T_GMIX)) { P_LAUNDER;
            pg8::Gemm g; EpiRes E; E.base0 = p.out; E.base1 = nullptr; E.out = p.out; E.scale = nullptr;
            if (type == T_GDOWN) { g = pg8::Gemm{(const bf16_t*)(p.ws + WS_V), (const bf16_t*)(p.ws + w_dn(layer)), MA, D, FF, FF, FF, 0}; }
            else if (layer == 0 || layer == 3) { g = pg8::Gemm{(const bf16_t*)(p.ws + WS_BIG), (const bf16_t*)(p.ws + w_mix(layer)), MA, D, 256, D, 256, 256}; E.scale = p.in[12] + (size_t)(layer / 3) * D;
                if (layer == 0) { E.base0 = p.in[0]; E.base1 = p.in[1]; } }
            else { g = pg8::Gemm{XN, (const bf16_t*)(p.ws + w_mix2(layer)), MA, D, D, D, D, 0}; }
            E.part = (float*)(p.ws + WS_PART); E.dry = (rp + 1 < reps);
            pg8::ResOrder S; S.init(g.K, G, bid); pg8::gemm_phase<EpiRes, pg8::ResOrder>(L, g, S, E, tid);
        } break;
        case T_GDNIN: if (EN(T_GDNIN)) { P_LAUNDER;
            pg8::Gemm g{XN, (const bf16_t*)(p.ws + w_mix(1)), MA, DNINP, D, D, D, 0}; pg8::StaticOrder S; S.init(MA, DNINP, D, G, bid);
            EpiDnIn E{(bf16_t*)(p.ws + WS_PRE), (bf16_t*)(p.out + O_KP), (float*)(p.ws + WS_AB), (bf16_t*)(p.ws + WS_HALO), p.out};
            pg8::gemm_phase<EpiDnIn, pg8::StaticOrder>(L, g, S, E, tid);
        } break;
        case T_DN2: if (EN(T_DN2)) { P_LAUNDER; dn_intra(p, L, tid, wave, bid, G, rp + 1 < reps); } break;
        case T_DN3: if (EN(T_DN3)) { P_LAUNDER; dn_scan(p, L, tid, wave, lane, bid, G); } break;
        case T_DN4: if (EN(T_DN4)) { P_LAUNDER; dn_outnorm(p, gw, NGW, lane); } break;
        case T_GQKV: if (EN(T_GQKV)) { P_LAUNDER;
            pg8::Gemm g{XN, (const bf16_t*)(p.ws + w_mix(2)), MA, 3 * D, D, D, D, 0}; pg8::StaticOrder S; S.init(MA, 3 * D, D, G, bid);
            EpiQkv E{(bf16_t*)(p.ws + WS_Q), (bf16_t*)(p.ws + WS_KP), (bf16_t*)(p.ws + WS_VTP), (bf16_t*)(p.ws + WS_KS), (bf16_t*)(p.ws + WS_VTS), p.out, L + 131072};
            pg8::gemm_phase<EpiQkv, pg8::StaticOrder>(L, g, S, E, tid);
        } break;
        case T_ATT: if (EN(T_ATT)) { P_LAUNDER; sb_attention(p, gw, NGW, lane); } break;
        case T_NF: if (EN(T_NF)) { P_LAUNDER; norm_rows<false>(p, p.in[9] + (size_t)layer * D, layer == 0 ? 2 : 0, (layer == 0 || layer == 3) ? 2 : 8, -1, gw, NGW, lane); } break;
        case T_GUP: if (EN(T_GUP)) { P_LAUNDER;
            EpiUp E{(bf16_t*)(p.ws + WS_V), (float*)(p.ws + WS_SG0), (float*)(p.ws + WS_SV0), (float*)(p.ws + WS_SGL), p.out, p.in[22] + (size_t)layer * 3 * FF, p.in[23] + (size_t)layer * FF, layer, p.in[7] + (size_t)layer * 8 * 2 * FF};
            { pg8::Gemm g{XN, (const bf16_t*)(p.ws + w_up(layer)), MP, NUP, D, D, D, 0}; pg8::StaticOrder S; S.init(MP, NUP, D, G, bid);
              pg8::gemm_phase<EpiUp, pg8::StaticOrder>(L, g, S, E, tid); }
            xcd_barrier(bar);
            if (bid < 44 || G <= 44) { pg8::Gemm g{XN, (const bf16_t*)(p.ws + w_up(layer)), MA, NUP, D, D, D, 0}; pg8::SampleUpOrder S; S.c = bid;
                for (int c2 = bid; c2 < 44; c2 += G) { S.c = c2; pg8::gemm_phase<EpiUp, pg8::SampleUpOrder>(L, g, S, E, tid); } }
            if (bid >= 44 || G <= 44) { const int nb = (G > 44) ? G - 44 : G, b0 = (G > 44) ? bid - 44 : bid;
                ffn_hidden(p, layer, b0 * 512 + tid, nb * 512);
                if (layer == 0) { LAS float* scr = (LAS float*)(L + wave * 16640); convert_layer_weights(p, 1, scr, b0 * 8 + wave, nb * 8, lane); } }
        } break;
        default: if (EN(T_FINAL)) { P_LAUNDER; norm_rows<true>(p, p.in[10], 0, FF / 128, -1, gw, NGW, lane); } break;
        }
        if (rp + 1 < reps) xcd_barrier(bar);
        }
        if (ph + 1 < p0.hi) xcd_barrier(bar);
#ifdef EXTRA_SYNCS
        if (ph == 0) { for (int q = 0; q < EXTRA_SYNCS; ++q) xcd_barrier(bar); }
#endif
    }
}

extern "C" void kernel_launch(void* const* d_in, const int* in_sizes, int n_in, void* d_out, int out_size, void* d_ws, size_t ws_size, hipStream_t stream) {
    static int grid = 0;
    if (grid == 0) {
        if (n_in != 25 || (size_t)out_size != O_END || ws_size < WS_END) { fprintf(stderr, "kernel_launch: unexpected shapes: n_in %d out %d ws %zu\n", n_in, out_size, ws_size); grid = -1; return; }
        int dev = 0, cus = 0, per_cu = 0;
        hipGetDevice(&dev); hipDeviceGetAttribute(&cus, hipDeviceAttributeMultiprocessorCount, dev);
        if (hipFuncSetAttribute((const void*)mega_fwd, hipFuncAttributeMaxDynamicSharedMemorySize, LDS_BYTES) != hipSuccess) { fprintf(stderr, "kernel_launch: hipFuncSetAttribute failed\n"); grid = -1; return; }
        if (hipOccupancyMaxActiveBlocksPerMultiprocessor(&per_cu, (const void*)mega_fwd, 512, LDS_BYTES) != hipSuccess || per_cu < 1) { fprintf(stderr, "kernel_launch: occupancy query says %d\n", per_cu); per_cu = 1; }
        (void)hipGetLastError();
        grid = cus * 1;
    }
    if (grid < 0) return;
    if (hipMemsetAsync((char*)d_ws + WS_CTL, 0, CTL_BYTES, stream) != hipSuccess) { fprintf(stderr, "kernel_launch: memset failed\n"); return; }
    Params p{};
    for (int i = 0; i < 25; ++i) p.in[i] = (const float*)d_in[i];
    p.out = (float*)d_out; p.ws = (unsigned char*)d_ws;
#if MK_ONE_LAUNCH
    p.lo = 0; p.hi = N_PHASES;
    void* args[] = {&p};
    hipError_t e = hipLaunchCooperativeKernel((const void*)mega_fwd, dim3(grid), dim3(512), args, LDS_BYTES, stream);
    if (e != hipSuccess) fprintf(stderr, "cooperative launch failed: %s (grid %d)\n", hipGetErrorString(e), grid);
#else
    for (int ph = 0; ph < N_PHASES; ++ph) { p.lo = ph; p.hi = ph + 1; hipLaunchKernelGGL(mega_fwd, dim3(grid), dim3(512), LDS_BYTES, stream, p); }
#endif
}
```
